# Optimizing an MI355X kernel written in HIP

```python
import jax, jax.numpy as jnp
from jax import lax
import numpy as np

D_MODEL = 2048
BATCH = 4
SEQ = 4096
DEPTH = 2

HEAD_DIM = 64
RWKV_WIDTH = 3 * D_MODEL // 8
POOL_WIDTH = D_MODEL // 4
SB_WIDTH = D_MODEL - RWKV_WIDTH - POOL_WIDTH
D_MIX = RWKV_WIDTH + POOL_WIDTH + SB_WIDTH
RWKV_HEADS = RWKV_WIDTH // HEAD_DIM
SB_HEADS = SB_WIDTH // HEAD_DIM
DECAY_RANK = 64
ICLR_RANK = 64
POOL_WINDOWS = (2, 4, 8, 16)
POOL_GROUPS = len(POOL_WINDOWS)
POOL_GROUP_WIDTH = POOL_WIDTH // POOL_GROUPS
SB_BLOCK = 128
RMS_EPS = 1e-6
GN_EPS = 64e-5
A_COLS = 4 * RWKV_WIDTH + DECAY_RANK + ICLR_RANK
B_COLS = 2 * POOL_WIDTH
C_COLS = 4 * SB_WIDTH
IN_COLS = A_COLS + B_COLS + C_COLS

kernel_name = "hymba_rwkv7_pool_stickbreak"


def _rms(x, g):
    xf = x.astype(jnp.float32)
    y = xf * lax.rsqrt(jnp.mean(jnp.square(xf), axis=-1, keepdims=True) + RMS_EPS)
    return (y * g.astype(jnp.float32)).astype(x.dtype)


def _split(u, sizes):
    cuts = [int(c) for c in np.cumsum(sizes)[:-1]]
    return jnp.split(u, cuts, axis=-1)


def _token_shift(u, mu):
    prev = jnp.pad(u, ((0, 0), (1, 0), (0, 0)))[:, :-1]
    return u + (prev - u) * mu


def _rwkv7(r, k, v, wd, ad, w_up, w0, a_up, a0, k_k, k_a, r_k, gn_g, gn_b):
    f32 = jnp.float32
    B, S, C = r.shape
    H, N = C // HEAD_DIM, HEAD_DIM
    r, k, v, wd, ad = (t.astype(f32) for t in (r, k, v, wd, ad))
    logw = -jax.nn.softplus(-(w0 + jnp.tanh(wd) @ w_up)) - 0.5
    decay = jnp.exp(-jnp.exp(logw))
    a = jax.nn.sigmoid(a0 + ad @ a_up)
    kk = (k * k_k).reshape(B, S, H, N)
    kk = kk / jnp.maximum(jnp.sqrt(jnp.sum(jnp.square(kk), axis=-1, keepdims=True)), 1e-12)
    k = k * (1.0 + (a - 1.0) * k_a)

    def heads_t(t):
        return t.reshape(B, S, H, N).transpose(1, 0, 2, 3)

    xs = (heads_t(r), heads_t(k), heads_t(v), heads_t(decay),
          kk.transpose(1, 0, 2, 3), heads_t(a))

    def step(state, inp):
        r_t, k_t, v_t, w_t, kk_t, a_t = inp
        sa = jnp.einsum('bhvk,bhk->bhv', state, -kk_t)
        state = (state * w_t[:, :, None, :]
                 + sa[..., None] * (kk_t * a_t)[:, :, None, :]
                 + v_t[..., None] * k_t[:, :, None, :])
        return state, jnp.einsum('bhvk,bhk->bhv', state, r_t)

    _, y = lax.scan(step, jnp.zeros((B, H, N, N), f32), xs)
    y = y.transpose(1, 0, 2, 3)
    mu = jnp.mean(y, axis=-1, keepdims=True)
    var = jnp.mean(jnp.square(y - mu), axis=-1, keepdims=True)
    y = ((y - mu) * lax.rsqrt(var + GN_EPS)).reshape(B, S, C) * gn_g + gn_b
    bonus = jnp.sum((r * k).reshape(B, S, H, N) * r_k, axis=-1, keepdims=True) * v.reshape(B, S, H, N)
    return y + bonus.reshape(B, S, C)


def _pool(u, pool_w, pool_scale):
    f32 = jnp.float32
    B, S, C = u.shape
    uf = u.astype(f32)
    cs = jnp.cumsum(uf, axis=1)
    pos = jnp.arange(1, S + 1, dtype=f32)[None, :, None]
    groups = []
    for gi, win in enumerate(POOL_WINDOWS):
        sl = slice(gi * POOL_GROUP_WIDTH, (gi + 1) * POOL_GROUP_WIDTH)
        c = cs[..., sl]
        lag = jnp.pad(c, ((0, 0), (win, 0), (0, 0)))[:, :S]
        mean = (c - lag) / jnp.minimum(pos, float(win))
        groups.append(mean - uf[..., sl])
    d = jnp.stack(groups, axis=2)
    y = jnp.einsum('bsgc,gcd->bsgd', d, pool_w.astype(f32)).reshape(B, S, C)
    return y * pool_scale


def _stick_breaking(q, k, v, qn_g, kn_g):
    f32 = jnp.float32
    B, S, C = q.shape
    H = C // HEAD_DIM

    def heads(t):
        return t.reshape(B, S, H, HEAD_DIM).transpose(0, 2, 1, 3)

    q = _rms(heads(q), qn_g).astype(f32) * (HEAD_DIM ** -0.5)
    k = _rms(heads(k), kn_g).astype(f32)
    v = heads(v).astype(f32)
    outs = []
    for q0 in range(0, S, SB_BLOCK):
        kend = q0 + SB_BLOCK
        z = jnp.einsum('bhqd,bhkd->bhqk', q[:, :, q0:kend], k[:, :, :kend])
        causal = jnp.arange(kend)[None, :] < (q0 + jnp.arange(SB_BLOCK))[:, None]
        log_1m = jnp.where(causal, jax.nn.log_sigmoid(-z), 0.0)
        after = lax.cumsum(log_1m, axis=3, reverse=True) - log_1m
        w = jnp.where(causal, jnp.exp(jax.nn.log_sigmoid(z) + after), 0.0)
        outs.append(jnp.einsum('bhqk,bhkd->bhqd', w, v[:, :, :kend]))
    o = jnp.concatenate(outs, axis=2)
    return o.transpose(0, 2, 1, 3).reshape(B, S, C)


def setup_inputs(seed: int = 0) -> dict:
    key = jax.random.key(seed)
    ks = jax.random.split(key, 20)
    f32 = jnp.float32
    nrm = lambda kk, shape, s: jax.random.normal(kk, shape, f32) * s
    L = DEPTH
    return {
        "x": nrm(ks[0], (BATCH, SEQ, D_MODEL), 1.0),
        "norm_g": 1.0 + nrm(ks[1], (L, D_MODEL), 0.02),
        "w_in": nrm(ks[2], (L, D_MODEL, IN_COLS), D_MODEL ** -0.5),
        "mu_a": jax.random.uniform(ks[3], (L, A_COLS), f32, 0.0, 1.0),
        "w_up": nrm(ks[4], (L, DECAY_RANK, RWKV_WIDTH), 0.1 * DECAY_RANK ** -0.5),
        "w0": jax.random.uniform(ks[5], (L, RWKV_WIDTH), f32, -6.0, 1.0),
        "a_up": nrm(ks[6], (L, ICLR_RANK, RWKV_WIDTH), 0.1 * ICLR_RANK ** -0.5),
        "a0": nrm(ks[7], (L, RWKV_WIDTH), 0.1),
        "k_k": 0.85 + nrm(ks[8], (L, RWKV_WIDTH), 0.02),
        "k_a": 1.0 + nrm(ks[9], (L, RWKV_WIDTH), 0.02),
        "r_k": nrm(ks[10], (L, RWKV_HEADS, HEAD_DIM), 0.1),
        "gn_g": 1.0 + nrm(ks[11], (L, RWKV_WIDTH), 0.02),
        "gn_b": nrm(ks[12], (L, RWKV_WIDTH), 0.02),
        "pool_w": nrm(ks[13], (L, POOL_GROUPS, POOL_GROUP_WIDTH, POOL_GROUP_WIDTH), POOL_GROUP_WIDTH ** -0.5),
        "pool_scale": 1.0 + nrm(ks[14], (L, POOL_WIDTH), 0.02),
        "qn_g": 1.0 + nrm(ks[15], (L, HEAD_DIM), 0.02),
        "kn_g": 1.0 + nrm(ks[16], (L, HEAD_DIM), 0.02),
        "w_out": nrm(ks[17], (L, D_MIX, D_MODEL), D_MIX ** -0.5),
    }


def reference(x, norm_g, w_in, mu_a, w_up, w0, a_up, a0, k_k, k_a, r_k, gn_g, gn_b,
              pool_w, pool_scale, qn_g, kn_g, w_out):
    f32 = jnp.float32
    for l in range(DEPTH):
        h = _rms(x, norm_g[l])
        proj = h @ w_in[l]
        pa, pb, pc = _split(proj, (A_COLS, B_COLS, C_COLS))
        pa = _token_shift(pa, mu_a[l])
        r, k, v, ga, wd, ad = _split(pa, (RWKV_WIDTH,) * 4 + (DECAY_RANK, ICLR_RANK))
        ya = _rwkv7(r, k, v, wd, ad, w_up[l], w0[l], a_up[l], a0[l], k_k[l], k_a[l],
                    r_k[l], gn_g[l], gn_b[l]) * jax.nn.silu(ga.astype(f32))
        pu, pg = _split(pb, (POOL_WIDTH, POOL_WIDTH))
        yb = _pool(pu, pool_w[l], pool_scale[l]) * jax.nn.silu(pg.astype(f32))
        qc, kc, vc, gc = _split(pc, (SB_WIDTH,) * 4)
        yc = _stick_breaking(qc, kc, vc, qn_g[l], kn_g[l]) * jax.nn.silu(gc.astype(f32))
        y = jnp.concatenate([ya, yb, yc], axis=-1).astype(x.dtype) @ w_out[l]
        x = x + y.astype(x.dtype)
    return x
```

```cpp
#include <hip/hip_runtime.h>
#include <hip/hip_cooperative_groups.h>
#include <cstdio>
namespace cg = cooperative_groups;
__device__ __forceinline__ int otid() { int t = threadIdx.x; asm volatile("" : "+v"(t)); return t; }
__device__ __forceinline__ int obid() { int b = blockIdx.x; asm volatile("" : "+s"(b)); return b; }
#ifndef MK_COOP
#define MK_COOP 1
#endif
namespace pg8 {
#define PG8_LAS __attribute__((address_space(3)))
typedef unsigned short bf16_t;
typedef short bf16x8 __attribute__((ext_vector_type(8)));
typedef float f32x4 __attribute__((ext_vector_type(4)));
typedef unsigned u32x4 __attribute__((ext_vector_type(4)));
constexpr int BM = 256, BK = 64, HALF = 128, HTB = HALF * BK * 2  , STAGE_BYTES = 8 * HTB, NXCD = 8, WGM = 8;

__host__ __device__ __forceinline__ int lds_byte(int r, int c) { const int st = (r >> 4) * 2 + (c >> 5), rr = r & 15, cc = c & 31, ob = rr * 64 + cc * 2; return st * 1024 + (ob ^ (((ob >> 9) & 1) << 5)); }
__host__ __device__ __forceinline__ void stage_rc(int b, int& R, int& C) { const int st = b / 1024, sb = b % 1024, swz = sb ^ (((sb >> 9) & 1) << 5); R = (st >> 1) * 16 + swz / 64; C = (st & 1) * 32 + (swz % 64) / 2; }
__host__ __device__ __forceinline__ int perm32(int rho) { const int n = rho >> 4, i = rho & 15; return 8 * (i >> 2) + 4 * n + (i & 3); }

struct Unit { int pm, pn; };
struct Gemm { const bf16_t* A; const bf16_t* Bt; int M, N, K; };
struct StaticOrder {
    int nM, nN, nwg, G, c;
    __host__ __device__ void init(int M, int N, int G_, int c_) { nM = M / BM; nN = N / BM; nwg = nM * nN; G = G_; c = c_; }
    __host__ __device__ bool next(int i, Unit& u) const {
        const long L = (long)i * G + c; if (L >= nwg) return false;
        int wgid = (int)L; { const int q = nwg / NXCD, r = nwg % NXCD, xcd = wgid % NXCD, off = wgid / NXCD; wgid = (xcd < r ? xcd * (q + 1) : r * (q + 1) + (xcd - r) * q) + off; }
        const int nig = WGM * nN, gid = wgid / nig, fm = gid * WGM, gsz = (nM - fm) < WGM ? (nM - fm) : WGM;
        u.pm = fm + ((wgid % nig) % gsz); u.pn = (wgid % nig) / gsz; return true;
    }
    __device__ __forceinline__ void a_ready(const Unit&) const {}
    __device__ __forceinline__ void done(const Unit&) const {}
};
__device__ __forceinline__ unsigned cvt_pk_bf16(float lo, float hi) { unsigned r; asm volatile("v_cvt_pk_bf16_f32 %0, %1, %2" : "=v"(r) : "v"(lo), "v"(hi)); return r; }
struct EpiBf16 {
    static constexpr bool PERM = true, AFTER_DRAIN = false;
    bf16_t* O; int ldc;
    __device__ __forceinline__ void operator()(const f32x4 (&acc)[2][2][4][2], const Unit& u, int wr, int wc, int fr, int fq) const {
        const int row0 = u.pm * BM + wr * 64 + fr; const int col0 = u.pn * BM + wc * 32 + 8 * fq;
#pragma unroll
        for (int ai = 0; ai < 2; ++ai)
#pragma unroll
            for (int m = 0; m < 4; ++m) { bf16_t* rowp = O + (size_t)(row0 + ai * HALF + m * 16) * ldc + col0;
#pragma unroll
                for (int bj = 0; bj < 2; ++bj) { const f32x4 v0 = acc[ai][bj][m][0], v1 = acc[ai][bj][m][1];
                    u32x4 w; w.x = cvt_pk_bf16(v0[0], v0[1]); w.y = cvt_pk_bf16(v0[2], v0[3]); w.z = cvt_pk_bf16(v1[0], v1[1]); w.w = cvt_pk_bf16(v1[2], v1[3]);
                    *(u32x4*)(rowp + bj * HALF) = w; } }
    }
};
struct EpiRes {
    static constexpr bool PERM = false, AFTER_DRAIN = false;
    const float* R; float* C; int ldc;
    __device__ __forceinline__ void operator()(const f32x4 (&acc)[2][2][4][2], const Unit& u, int wr, int wc, int fr, int fq) const {
        const int row0 = u.pm * BM + wr * 64 + fr, col0 = u.pn * BM + wc * 32 + 4 * fq;
#pragma unroll
        for (int ai = 0; ai < 2; ++ai)
#pragma unroll
            for (int mp = 0; mp < 2; ++mp) {
                f32x4 rr[2][2][2];
#pragma unroll
                for (int mm = 0; mm < 2; ++mm) { const size_t off = (size_t)(row0 + ai * HALF + (2 * mp + mm) * 16) * ldc + col0;
#pragma unroll
                    for (int bj = 0; bj < 2; ++bj)
#pragma unroll
                        for (int n = 0; n < 2; ++n) rr[mm][bj][n] = *(const f32x4*)(R + off + bj * HALF + n * 16); }
#pragma unroll
                for (int mm = 0; mm < 2; ++mm) { const size_t off = (size_t)(row0 + ai * HALF + (2 * mp + mm) * 16) * ldc + col0;
#pragma unroll
                    for (int bj = 0; bj < 2; ++bj)
#pragma unroll
                        for (int n = 0; n < 2; ++n) *(f32x4*)(C + off + bj * HALF + n * 16) = acc[ai][bj][2 * mp + mm][n] + rr[mm][bj][n]; }
            }
    }
};
template <class Epi, class Sched>
__device__ __forceinline__ void gemm_phase(PG8_LAS unsigned char* lds, const Gemm g, const Sched& S, const Epi& E) {
    const int tid = otid(), wid = __builtin_amdgcn_readfirstlane(tid >> 6), lane = tid & 63, wr = wid >> 2, wc = wid & 3, fr = lane & 15, fq = lane >> 4;
    const int K = g.K, nt = K / BK;
    unsigned voffA[2], voffB[2];
#pragma unroll
    for (int i = 0; i < 2; ++i) { int R, C; stage_rc(tid * 16 + i * 8192, R, C); const int Rb = Epi::PERM ? ((R & ~31) + perm32(R & 31)) : R;
        voffA[i] = (unsigned)(R * K + C) * 2u; voffB[i] = (unsigned)(Rb * K + C) * 2u; }
    const size_t kstep = (size_t)(BK * 2);
    const size_t hstep = (size_t)HALF * K * 2;
    const size_t tstep = 2 * hstep;
    const unsigned ldsw = (unsigned)wid * 1024u;
    const int aoff = lds_byte(wr * 64 + fr, fq * 8), boff = lds_byte(wc * 32 + fr, fq * 8);
#define PG8_SA(b, h) (((b) * 2 + (h)) * HTB)
#define PG8_SB(b, h) ((4 + (b) * 2 + (h)) * HTB)
#define PG8_STAGE(bufoff, gbase, voff) do { _Pragma("unroll") for (int _i = 0; _i < 2; ++_i) \
        __builtin_amdgcn_global_load_lds((const unsigned*)((const char*)(gbase) + (voff)[_i]), (PG8_LAS unsigned*)(lds + (bufoff) + ldsw + _i * 8192), 16, 0, 0); } while (0)
#define PG8_LDA(dst, b, h) do { _Pragma("unroll") for (int m = 0; m < 4; ++m) _Pragma("unroll") for (int k = 0; k < 2; ++k) dst[m][k] = *(const PG8_LAS bf16x8*)(lds + PG8_SA(b, h) + aoff + m * 2048 + k * 1024); } while (0)
#define PG8_LDB(dst, b, h) do { _Pragma("unroll") for (int n = 0; n < 2; ++n) _Pragma("unroll") for (int k = 0; k < 2; ++k) dst[n][k] = *(const PG8_LAS bf16x8*)(lds + PG8_SB(b, h) + boff + n * 2048 + k * 1024); } while (0)
#define PG8_MMA(ai, bj, At, Bt) do { __builtin_amdgcn_s_setprio(1); _Pragma("unroll") for (int m = 0; m < 4; ++m) _Pragma("unroll") for (int n = 0; n < 2; ++n) _Pragma("unroll") for (int k = 0; k < 2; ++k) \
        acc[ai][bj][m][n] = __builtin_amdgcn_mfma_f32_16x16x32_bf16(Bt[n][k], At[m][k], acc[ai][bj][m][n], 0, 0, 0); __builtin_amdgcn_s_setprio(0); } while (0)
#define PG8_WAIT_V(n) asm volatile("s_waitcnt vmcnt(" #n ")" ::: "memory")
#define PG8_WAIT_L(n) asm volatile("s_waitcnt lgkmcnt(" #n ")" ::: "memory")
#define PG8_BAR __builtin_amdgcn_s_barrier()
#define PG8_SCHED __builtin_amdgcn_sched_barrier(0)
    Unit cur, nxt; int ui = 0;
    if (!S.next(0, cur)) return;
    f32x4 acc[2][2][4][2];
#pragma unroll
    for (int a = 0; a < 2; ++a)
#pragma unroll
        for (int b = 0; b < 2; ++b)
#pragma unroll
            for (int m = 0; m < 4; ++m)
#pragma unroll
                for (int n = 0; n < 2; ++n) acc[a][b][m][n] = (f32x4){0.f, 0.f, 0.f, 0.f};
    bf16x8 At[4][2], B0[2][2], B1[2][2];
    const char* cA = (const char*)g.A + (size_t)cur.pm * tstep; const char* cB = (const char*)g.Bt + (size_t)cur.pn * tstep;
    S.a_ready(cur);
    PG8_STAGE(PG8_SB(0, 0), cB, voffB); PG8_STAGE(PG8_SA(0, 0), cA, voffA); PG8_STAGE(PG8_SB(0, 1), cB + hstep, voffB); PG8_STAGE(PG8_SA(0, 1), cA + hstep, voffA);
    if (wr == 1) PG8_BAR;
    PG8_WAIT_V(4); PG8_BAR;
    PG8_STAGE(PG8_SB(1, 0), cB + kstep, voffB); PG8_STAGE(PG8_SA(1, 0), cA + kstep, voffA); PG8_STAGE(PG8_SB(1, 1), cB + hstep + kstep, voffB);
    PG8_WAIT_V(6); PG8_BAR;
    for (;;) {
        const bool has_next = S.next(ui + 1, nxt);
        const char* nA = has_next ? (const char*)g.A + (size_t)nxt.pm * tstep : cA; const char* nB = has_next ? (const char*)g.Bt + (size_t)nxt.pn * tstep : cB;
        for (int t = 0; t < nt; t += 2) {
            const bool last = (t == nt - 2);
            const char* a1 = cA + (size_t)(t + 1) * kstep;
            const char* a2 = last ? nA : cA + (size_t)(t + 2) * kstep; const char* b2 = last ? nB : cB + (size_t)(t + 2) * kstep;
            const char* a3 = a2 + kstep; const char* b3 = b2 + kstep;
            if (last && has_next) S.a_ready(nxt);
            PG8_LDB(B0, 0, 0); PG8_SCHED; PG8_LDA(At, 0, 0); PG8_STAGE(PG8_SA(1, 1), a1 + hstep, voffA);
            PG8_WAIT_L(8); PG8_BAR; PG8_WAIT_L(0); PG8_MMA(0, 0, At, B0); PG8_BAR; PG8_SCHED;
            PG8_LDB(B1, 0, 1); PG8_STAGE(PG8_SB(0, 0), b2, voffB);
            PG8_BAR; PG8_WAIT_L(0); PG8_MMA(0, 1, At, B1); PG8_BAR;
            PG8_LDA(At, 0, 1); PG8_STAGE(PG8_SA(0, 0), a2, voffA);
            PG8_BAR; PG8_WAIT_L(0); PG8_MMA(1, 0, At, B0); PG8_BAR; PG8_SCHED;
            PG8_STAGE(PG8_SB(0, 1), b2 + hstep, voffB);
            PG8_WAIT_V(6); PG8_BAR; PG8_MMA(1, 1, At, B1); PG8_BAR;
            PG8_LDB(B0, 1, 0); PG8_SCHED; PG8_LDA(At, 1, 0); PG8_STAGE(PG8_SA(0, 1), a2 + hstep, voffA);
            PG8_WAIT_L(8); PG8_BAR; PG8_WAIT_L(0); PG8_MMA(0, 0, At, B0); PG8_BAR; PG8_SCHED;
            PG8_LDB(B1, 1, 1); PG8_STAGE(PG8_SB(1, 0), b3, voffB);
            PG8_BAR; PG8_WAIT_L(0); PG8_MMA(0, 1, At, B1); PG8_BAR;
            PG8_LDA(At, 1, 1); PG8_STAGE(PG8_SA(1, 0), a3, voffA);
            PG8_BAR; PG8_WAIT_L(0); PG8_MMA(1, 0, At, B0); PG8_BAR; PG8_SCHED;
            PG8_STAGE(PG8_SB(1, 1), b3 + hstep, voffB);
            PG8_WAIT_V(6); PG8_BAR; PG8_MMA(1, 1, At, B1); PG8_BAR;
        }
        if constexpr (!Epi::AFTER_DRAIN) { E(acc, cur, wr, wc, fr, fq); S.done(cur); }
        if (!has_next) break;
#pragma unroll
        for (int a = 0; a < 2; ++a)
#pragma unroll
            for (int b = 0; b < 2; ++b)
#pragma unroll
                for (int m = 0; m < 4; ++m)
#pragma unroll
                    for (int n = 0; n < 2; ++n) acc[a][b][m][n] = (f32x4){0.f, 0.f, 0.f, 0.f};
        cur = nxt; cA = nA; cB = nB; ++ui;
    }
    PG8_WAIT_V(0);
    if (wr == 0) PG8_BAR;
    PG8_BAR;
    if constexpr (Epi::AFTER_DRAIN) { E.fused(acc, cur, wr, wc, fr, fq, lds, wid, lane); S.done(cur); }
#undef PG8_SA
#undef PG8_SB
#undef PG8_STAGE
#undef PG8_LDA
#undef PG8_LDB
#undef PG8_MMA
#undef PG8_WAIT_V
#undef PG8_WAIT_L
#undef PG8_BAR
#undef PG8_SCHED
}
}
#define XB_TMO      128
#define XB_XCNT(j)  (256  + 64 * (j))
#define XB_XSUB(j)  (1280 + 64 * (j))
#define XB_XGEN(j)  (2304 + 64 * (j))
#define XB_TOP      3328
#define XB_TOPGEN   3392
#define XCD_BAR_WORDS 3456
#define XB_SPIN_CAP (1u << 18)
#define LAS __attribute__((address_space(3)))

__device__ __forceinline__ unsigned xb_ld(unsigned* p)              { return __hip_atomic_load(p, __ATOMIC_RELAXED, __HIP_MEMORY_SCOPE_AGENT); }
__device__ __forceinline__ unsigned xb_add(unsigned* p, unsigned v) { return __hip_atomic_fetch_add(p, v, __ATOMIC_RELAXED, __HIP_MEMORY_SCOPE_AGENT); }
__device__ __forceinline__ unsigned xb_xcc_id() { return (unsigned)__builtin_amdgcn_s_getreg((3 << 11) | 20) & 0xFu; }
#define XB_SPIN(cond, bar) do { unsigned _sp = 0; while (cond) { __builtin_amdgcn_s_sleep(1); \
    if ((++_sp & 255u) == 0u) { if (xb_ld(&(bar)[XB_TMO])) break; if (_sp > XB_SPIN_CAP) { atomicAdd(&(bar)[XB_TMO], 1u); break; } } } } while (0)
struct XcdBarrier {
    unsigned* bar; unsigned x;
    volatile LAS unsigned* st;
};

__device__ __forceinline__ XcdBarrier xcd_barrier_post(unsigned* bar, volatile LAS unsigned* st) {
    XcdBarrier b; b.bar = bar; b.x = xb_xcc_id(); b.st = st;
    if (threadIdx.x == 0) (void)xb_add(&bar[XB_XCNT(b.x)], 1u);
    return b;
}
__device__ __forceinline__ void xcd_barrier_complete(unsigned* bar, unsigned x, unsigned& nloc, unsigned& nx) {
    const unsigned G = gridDim.x * gridDim.y * gridDim.z;
    unsigned sum, cnt, mine, sp = 0u;
    for (;;) {
        sum = 0u; cnt = 0u; mine = 0u;
#pragma unroll
        for (unsigned j = 0; j < 16; ++j) { const unsigned c = xb_ld(&bar[XB_XCNT(j)]); sum += c; cnt += (c > 0u) ? 1u : 0u; mine = (j == x) ? c : mine; }
        if (sum == G) break;
        __builtin_amdgcn_s_sleep(1);
        if ((++sp & 255u) == 0u) { if (xb_ld(&bar[XB_TMO])) break; if (sp > XB_SPIN_CAP) { atomicAdd(&bar[XB_TMO], 1u); break; } }
    }
    nloc = mine > 0u ? mine : 1u; nx = cnt > 0u ? cnt : 1u;
}

__device__ __forceinline__ void xcd_barrier(const XcdBarrier& b) {
    asm volatile("s_waitcnt vmcnt(0)" ::: "memory");
    __syncthreads();
    if (threadIdx.x == 0) {
        unsigned* bar = b.bar;
        __builtin_amdgcn_s_waitcnt(0);
        unsigned nloc = b.st[0], nx = b.st[1];
        if (nloc == 0u) { xcd_barrier_complete(bar, b.x, nloc, nx); b.st[0] = nloc; b.st[1] = nx; }
        const unsigned old = xb_add(&bar[XB_XSUB(b.x)], 1u);
        const unsigned gen = old / nloc;
        if (old + 1u == (gen + 1u) * nloc) {
            __builtin_amdgcn_fence(__ATOMIC_RELEASE, "agent");
            asm volatile("s_waitcnt vmcnt(0)" ::: "memory");
            const unsigned og = xb_add(&bar[XB_TOP], 1u);
            const unsigned tg = og / nx;
            if (og + 1u == (tg + 1u) * nx) xb_add(&bar[XB_TOPGEN], 1u);
            else XB_SPIN(xb_ld(&bar[XB_TOPGEN]) == tg, bar);
            __builtin_amdgcn_fence(__ATOMIC_ACQUIRE, "agent");
            xb_add(&bar[XB_XGEN(b.x)], 1u);
            asm volatile("s_waitcnt vmcnt(0)" ::: "memory");
        } else {
            XB_SPIN(xb_ld(&bar[XB_XGEN(b.x)]) == gen, bar);
            __builtin_amdgcn_fence(__ATOMIC_ACQUIRE, "agent");
            asm volatile("s_waitcnt vmcnt(0)" ::: "memory");
        }
    }
    __syncthreads();
}

typedef unsigned short u16;
typedef short bf16x8 __attribute__((ext_vector_type(8)));
typedef float f32x16 __attribute__((ext_vector_type(16)));
#define DI __device__ __forceinline__
constexpr int MTOK = 16384, SEQ = 4096, DM = 2048, NPJ = 7424, NIN = 7296, NH = 12, NG1 = 7168;
constexpr int C_R = 0, C_K = 768, C_V = 1536, C_G = 2304, C_WD = 3072, C_PU = 3200, C_PG = 3712, C_AQ = 4224, C_AK = 4992, C_AV = 5760, C_AG = 6528;
constexpr int LDS_BYTES = 148 * 1024 + 64;

struct Params {
    const float *x, *norm_g, *w_in, *mu_a, *w_up, *w0, *a_up, *a0, *k_k, *k_a, *r_k, *gn_g, *gn_b, *pool_w, *pool_scale, *qn_g, *kn_g, *w_out;
    float* out;
    u16 *W1, *W2, *HB, *PJ, *KR, *VF, *GH, *WUT, *AUT, *PWT;
    float *GC, *SBN;
    unsigned* BAR;
};

DI float bf2f(u16 b) { return __uint_as_float(((unsigned)b) << 16); }
typedef __bf16 hwbf16x2 __attribute__((ext_vector_type(2)));
typedef float hwf32x2 __attribute__((ext_vector_type(2)));
DI unsigned pk2(float lo, float hi) { const hwf32x2 f = {lo, hi}; return __builtin_bit_cast(unsigned, __builtin_convertvector(f, hwbf16x2)); }
DI u16 f2bf(float f) { return (u16)(pk2(f, 0.f) & 0xffffu); }
DI float bflo(unsigned u) { return __uint_as_float(u << 16); }
DI float bfhi(unsigned u) { return __uint_as_float(u & 0xffff0000u); }
DI float silu(float x) { return x / (1.f + __expf(-x)); }
DI float wave_sum(float v) {
#pragma unroll
    for (int o = 32; o > 0; o >>= 1) v += __shfl_xor(v, o);
    return v;
}
template <int CTRL> DI float dpp_mov(float x) { return __builtin_bit_cast(float, __builtin_amdgcn_update_dpp(0, __builtin_bit_cast(int, x), CTRL, 0xf, 0xf, false)); }
DI float row16_sum(float x) {
    x += dpp_mov<0xB1>(x); x += dpp_mov<0x4E>(x); x += dpp_mov<0x141>(x); x += dpp_mov<0x140>(x); return x;
}

constexpr int ILD = 72, IMG = 64 * ILD;
DI f32x16 f16zero() { f32x16 z;
#pragma unroll
    for (int i = 0; i < 16; ++i) z[i] = 0.f; return z; }

DI void convert_weights(const Params& p, int l, unsigned char* shm, int u0, int ustride, int ubeg, int uend) {
    const int tid = otid();
    float* sT = (float*)shm;
    const float* win = p.w_in + (size_t)l * DM * NIN;
    const float* wout = p.w_out + (size_t)l * DM * DM;
    const int nW1 = 32 * (NPJ / 256);
    float4 v0, v1, v2, v3, v4, v5, v6, v7;
    auto ldv = [&](int u, int i) __attribute__((always_inline)) -> float4 {
        const float* src; int N, kt, nt;
        if (u < nW1) { kt = u & 31; nt = u >> 5; src = win; N = NIN; } else { const int w2 = u - nW1; kt = w2 & 31; nt = w2 >> 5; src = wout; N = DM; }
        const int kk = (tid >> 6) + 8 * i, nn = (tid & 63) * 4;
        float4 r = make_float4(0.f, 0.f, 0.f, 0.f);
        if (nt * 256 + nn < N) r = *(const float4*)(src + (size_t)(kt * 64 + kk) * N + nt * 256 + nn);
        return r;
    };
#define CW_LOAD(U) do { v0 = ldv(U, 0); v1 = ldv(U, 1); v2 = ldv(U, 2); v3 = ldv(U, 3); v4 = ldv(U, 4); v5 = ldv(U, 5); v6 = ldv(U, 6); v7 = ldv(U, 7); } while (0)
#define CW_PARK(I, V) do { const int kk = (tid >> 6) + 8 * (I), nn = (tid & 63) * 4; sT[kk * 257 + nn + 0] = V.x; sT[kk * 257 + nn + 1] = V.y; sT[kk * 257 + nn + 2] = V.z; sT[kk * 257 + nn + 3] = V.w; } while (0)
    if (ubeg + u0 < uend) CW_LOAD(ubeg + u0);
    for (int u = ubeg + u0; u < uend; u += ustride) {
        u16* dst; int kt, nt;
        if (u < nW1) { kt = u & 31; nt = u >> 5; dst = p.W1; } else { const int w2 = u - nW1; kt = w2 & 31; nt = w2 >> 5; dst = p.W2; }
        const int k0 = kt * 64, n0 = nt * 256;
        CW_PARK(0, v0); CW_PARK(1, v1); CW_PARK(2, v2); CW_PARK(3, v3); CW_PARK(4, v4); CW_PARK(5, v5); CW_PARK(6, v6); CW_PARK(7, v7);
        __syncthreads();
        if (u + ustride < uend) CW_LOAD(u + ustride);
        {
            const int nn = tid >> 1, ks = (tid & 1) * 32;
#pragma unroll
            for (int c4 = 0; c4 < 4; ++c4) {
                const int kb = ks + c4 * 8;
                uint4 o;
                o.x = pk2(sT[(kb + 0) * 257 + nn], sT[(kb + 1) * 257 + nn]); o.y = pk2(sT[(kb + 2) * 257 + nn], sT[(kb + 3) * 257 + nn]);
                o.z = pk2(sT[(kb + 4) * 257 + nn], sT[(kb + 5) * 257 + nn]); o.w = pk2(sT[(kb + 6) * 257 + nn], sT[(kb + 7) * 257 + nn]);
                *(uint4*)(dst + (size_t)(n0 + nn) * DM + k0 + kb) = o;
            }
        }
        __syncthreads();
    }
#undef CW_LOAD
#undef CW_PARK
}

DI void phase_p1(const Params& p, int l, unsigned char* shm) {
    const int tid = otid(), wave = tid >> 6, lane = tid & 63;
    const int nW1 = 32 * (NPJ / 256), nW2 = 32 * (DM / 256);
    const float* xin = l == 0 ? p.x : p.out;
    const float* g = p.norm_g + l * DM;
    float4 gq[8];
#pragma unroll
    for (int i = 0; i < 8; ++i) gq[i] = *(const float4*)(g + i * 256 + lane * 4);
    const int rstep = gridDim.x * 16;
    int row = (obid() * 8 + wave) * 2;
    float4 v[16];
    if (row < MTOK) {
#pragma unroll
        for (int i = 0; i < 16; ++i) v[i] = *(const float4*)(xin + (size_t)(row + (i >> 3)) * DM + (i & 7) * 256 + lane * 4);
    }
    convert_weights(p, l, shm, obid(), gridDim.x, l == 0 ? 0 : nW1, nW1 + nW2);
    {
        const float* w_up = p.w_up + l * 64 * 768; const float* a_up = p.a_up + l * 64 * 768; const float* pool_w = p.pool_w + (size_t)l * 4 * 128 * 128;
        for (int e = obid() * 512 + tid; e < 768 * 64; e += gridDim.x * 512) { const int c = e >> 6, j = e & 63; p.WUT[e] = f2bf(w_up[j * 768 + c]); p.AUT[e] = f2bf(a_up[j * 768 + c]); }
        for (int e = obid() * 512 + tid; e < 4 * 128 * 128; e += gridDim.x * 512) { const int g2 = e >> 14, dd = (e >> 7) & 127, c = e & 127; p.PWT[e] = f2bf(pool_w[(g2 * 128 + c) * 128 + dd]); }
    }
#pragma unroll 1
    for (; row < MTOK; row += rstep) {
        float4 vn[16];
        const int rown = row + rstep;
        if (rown < MTOK) {
#pragma unroll
            for (int i = 0; i < 16; ++i) vn[i] = *(const float4*)(xin + (size_t)(rown + (i >> 3)) * DM + (i & 7) * 256 + lane * 4);
        }
        float ss0 = 0.f, ss1 = 0.f;
#pragma unroll
        for (int i = 0; i < 8; ++i) { ss0 += v[i].x * v[i].x + v[i].y * v[i].y + v[i].z * v[i].z + v[i].w * v[i].w; ss1 += v[8 + i].x * v[8 + i].x + v[8 + i].y * v[8 + i].y + v[8 + i].z * v[8 + i].z + v[8 + i].w * v[8 + i].w; }
        ss0 = wave_sum(ss0); ss1 = wave_sum(ss1);
        const float inv0 = rsqrtf(ss0 * (1.f / DM) + 1e-6f), inv1 = rsqrtf(ss1 * (1.f / DM) + 1e-6f);
#pragma unroll
        for (int i = 0; i < 16; ++i) {
            const float inv = (i < 8) ? inv0 : inv1;
            const float4 gg = gq[i & 7];
            uint2 o; o.x = pk2(v[i].x * inv * gg.x, v[i].y * inv * gg.y); o.y = pk2(v[i].z * inv * gg.z, v[i].w * inv * gg.w);
            *(uint2*)(p.HB + (size_t)(row + (i >> 3)) * DM + (i & 7) * 256 + lane * 4) = o;
        }
        if (rown < MTOK) {
#pragma unroll
            for (int i = 0; i < 16; ++i) v[i] = vn[i];
        }
    }
}

DI float wave_sum_fast(float x) {
    const int xi = __builtin_bit_cast(int, row16_sum(x));
    const float s0 = __builtin_bit_cast(float, __builtin_amdgcn_readlane(xi, 0)), s1 = __builtin_bit_cast(float, __builtin_amdgcn_readlane(xi, 16));
    const float s2 = __builtin_bit_cast(float, __builtin_amdgcn_readlane(xi, 32)), s3 = __builtin_bit_cast(float, __builtin_amdgcn_readlane(xi, 48));
    return (s0 + s1) + (s2 + s3);
}
DI float frcp(float x) { return __builtin_amdgcn_rcpf(x); }
DI void phase_p3(const Params& p, int l, unsigned char* shm) {
    const float* mu = p.mu_a + l * 3200;
    const float* w0 = p.w0 + l * 768; const float* a0 = p.a0 + l * 768; const float* k_k = p.k_k + l * 768; const float* k_a = p.k_a + l * 768; const float* r_k = p.r_k + l * 768;
    const float* pool_scale = p.pool_scale + l * 512;
    const float* qn_g = p.qn_g + l * 64; const float* kn_g = p.kn_g + l * 64;
    constexpr int DLD = 520;
    u16* sXW = (u16*)shm;
    u16* sXA = sXW + 32 * ILD;
    u16* sD = sXA + 32 * ILD;
    float* sLG = (float*)(sD + 32 * DLD);
    u16* sRAW = (u16*)(sLG + 768);
    u16* MIX = p.HB;
    for (int unit2 = obid() * 2; unit2 < MTOK / 32; unit2 += gridDim.x * 2)
    for (int sub = 0; sub < 2; ++sub) {
        if (sub == 0) {
            const int tid = otid(), wave = __builtin_amdgcn_readfirstlane(tid >> 6), lane = tid & 63, r = lane & 31, hh = lane >> 5;
            constexpr int TLD = 136;
            u16* sTA = (u16*)shm; u16* sTB = sTA + 64 * TLD;
            const int trw = wave >> 2, tcw = wave & 3;
            auto t0_src = [&](int jj, int kc) __attribute__((always_inline)) -> const u16* {
                const int idx = tid + 512 * (jj < 2 ? jj : jj - 2), row = idx >> 4, c16 = idx & 15;
                return (jj < 2) ? p.HB + (size_t)(unit2 * 32 + row) * DM + kc * 128 + c16 * 8 : p.W1 + (size_t)(NG1 + row) * DM + kc * 128 + c16 * 8;
            };
            constexpr int TBUF = 192 * TLD;
            auto t0_dst = [&](int jj, int buf) __attribute__((always_inline)) -> u16* {
                const int idx = tid + 512 * (jj < 2 ? jj : jj - 2), row = idx >> 4, c16 = idx & 15;
                return ((jj < 2) ? sTA : sTB) + buf * TBUF + row * TLD + c16 * 8;
            };
            uint4 pf0, pf1, pf2, pf3, pf4, pf5;
#define T0_ISSUE(KC) do { pf0 = *(const uint4*)t0_src(0, KC); pf1 = *(const uint4*)t0_src(1, KC); pf2 = *(const uint4*)t0_src(2, KC); pf3 = *(const uint4*)t0_src(3, KC); pf4 = *(const uint4*)t0_src(4, KC); pf5 = *(const uint4*)t0_src(5, KC); } while (0)
#define T0_PARK(BUF) do { *(uint4*)t0_dst(0, BUF) = pf0; *(uint4*)t0_dst(1, BUF) = pf1; *(uint4*)t0_dst(2, BUF) = pf2; *(uint4*)t0_dst(3, BUF) = pf3; *(uint4*)t0_dst(4, BUF) = pf4; *(uint4*)t0_dst(5, BUF) = pf5; } while (0)
            T0_ISSUE(0);
            T0_PARK(0);
            T0_ISSUE(1);
            __syncthreads();
            f32x16 z = f16zero();
#pragma unroll 1
            for (int kc = 0; kc < 16; ++kc) {
                const u16* cA = sTA + (kc & 1) * TBUF; const u16* cB = sTB + (kc & 1) * TBUF;
#pragma unroll 4
                for (int s = 0; s < 8; ++s) {
                    const bf16x8 a = *(const bf16x8*)(cA + (32 * trw + r) * TLD + 16 * s + 8 * hh), bq = *(const bf16x8*)(cB + (32 * tcw + r) * TLD + 16 * s + 8 * hh);
                    z = __builtin_amdgcn_mfma_f32_32x32x16_bf16(a, bq, z, 0, 0, 0);
                }
                if (kc + 1 < 16) { T0_PARK((kc + 1) & 1); if (kc + 2 < 16) T0_ISSUE(kc + 2); }
                __syncthreads();
            }
#undef T0_PARK
#undef T0_ISSUE
#pragma unroll
            for (int i = 0; i < 16; ++i) p.PJ[(size_t)(unit2 * 32 + 32 * trw + 8 * (i >> 2) + 4 * hh + (i & 3)) * NPJ + NG1 + 32 * tcw + r] = f2bf(z[i]);
        }
        const int tid = otid(), wave = __builtin_amdgcn_readfirstlane(tid >> 6), lane = tid & 63, r = lane & 31, hh = lane >> 5;
        u16* sSCR = sRAW + wave * 4096;
        const int unit = unit2 + sub;
        const int t0 = unit * 32, b = t0 >> 12, s0 = t0 & (SEQ - 1);
#pragma unroll
        for (int e = tid; e < 32 * 128; e += 512) {
            const int tok = e >> 7, j = e & 127, col = C_WD + j;
            const size_t row = (size_t)(t0 + tok);
            const float cur = bf2f(p.PJ[row * NPJ + col]);
            const float prv = (s0 + tok > 0) ? bf2f(p.PJ[(row - 1) * NPJ + col]) : 0.f;
            const float v = cur + (prv - cur) * mu[col];
            if (j < 64) sXW[tok * ILD + j] = f2bf(1.f - 2.f * frcp(1.f + __expf(2.f * v)));
            else sXA[tok * ILD + (j - 64)] = f2bf(v);
        }
#pragma unroll
        for (int e = tid; e < 47 * 64; e += 512) {
            const int rr = e >> 6, seg = (e & 63) * 8, s = s0 - 15 + rr;
            uint4 v = make_uint4(0u, 0u, 0u, 0u);
            if (s >= 0) v = *(const uint4*)(p.PJ + (size_t)(t0 - 15 + rr) * NPJ + C_PU + seg);
            *(uint4*)(sRAW + rr * 512 + seg) = v;
        }
        __syncthreads();
        {
            const int c = tid, win = 2 << (c >> 7);
            float raw[47];
#pragma unroll
            for (int i = 0; i < 47; ++i) raw[i] = bf2f(sRAW[i * 512 + c]);
            float run = 0.f;
#pragma unroll
            for (int j = 1; j < 16; ++j) run += (j < win) ? raw[15 - j] : 0.f;
#pragma unroll
            for (int tok = 0; tok < 32; ++tok) {
                const int s = s0 + tok; const int n = (s + 1 < win) ? (s + 1) : win;
                const float uu = raw[15 + tok];
                run += uu;
                sD[tok * DLD + c] = f2bf(run * frcp((float)n) - uu);
                const float o2 = raw[15 + tok - 1], o4 = raw[15 + tok - 3], o8 = raw[15 + tok - 7], o16 = raw[15 + tok - 15];
                run -= (win == 2) ? o2 : (win == 4) ? o4 : (win == 8) ? o8 : o16;
            }
        }
        __syncthreads();
#pragma unroll 1
        for (int rnd = 0; rnd < 2; ++rnd) {
            const int hd = rnd ? 8 + (wave & 3) : wave;
            const int segb = rnd ? (wave >> 2) : 0, sege = rnd ? segb + 1 : 2;
            {
#pragma unroll 1
                for (int mat = 0; mat < 2; ++mat) {
                    const u16* X = mat ? sXA : sXW; const u16* WT = mat ? p.AUT : p.WUT;
                    f32x16 z0 = f16zero(), z1 = f16zero();
#pragma unroll
                    for (int s = 0; s < 4; ++s) {
                        const bf16x8 xf = *(const bf16x8*)(X + r * ILD + 16 * s + 8 * hh);
                        const bf16x8 w0f = *(const bf16x8*)(WT + (size_t)(hd * 64 + r) * 64 + 16 * s + 8 * hh), w1f = *(const bf16x8*)(WT + (size_t)(hd * 64 + 32 + r) * 64 + 16 * s + 8 * hh);
                        z0 = __builtin_amdgcn_mfma_f32_32x32x16_bf16(xf, w0f, z0, 0, 0, 0); z1 = __builtin_amdgcn_mfma_f32_32x32x16_bf16(xf, w1f, z1, 0, 0, 0);
                    }
#pragma unroll
                    for (int i = 0; i < 16; ++i) {
                        const int tok = 8 * (i >> 2) + 4 * hh + (i & 3);
                        sSCR[mat * 2048 + tok * 64 + r] = f2bf(z0[i]); sSCR[mat * 2048 + tok * 64 + 32 + r] = f2bf(z1[i]);
                    }
                }
                __builtin_amdgcn_fence(__ATOMIC_RELEASE, "workgroup"); __builtin_amdgcn_wave_barrier(); __builtin_amdgcn_fence(__ATOMIC_ACQUIRE, "workgroup");
            }
            const int c = hd * 64 + lane, n = lane, bh = b * NH + hd;
            const float w0c = w0[c], a0c = a0[c], kkc = k_k[c], kac = k_a[c], rkc = r_k[c], mur = mu[C_R + c], muk = mu[C_K + c];
            float lg = sub ? sLG[c] : 0.f;
            const u16* pk = p.PJ + (size_t)t0 * NPJ + C_K + c; const u16* pr = p.PJ + (size_t)t0 * NPJ + C_R + c;
            float kp = 0.f, rp = 0.f;
            if (segb == 0) { if (s0 > 0) { kp = bf2f(*(pk - NPJ)); rp = bf2f(*(pr - NPJ)); } }
            else {
                kp = bf2f(pk[(size_t)15 * NPJ]); rp = bf2f(pr[(size_t)15 * NPJ]);
#pragma unroll
                for (int t = 0; t < 16; ++t) lg -= 0.60653066f * frcp(1.f + __expf(-(w0c + bf2f(sSCR[t * 64 + n]))));
            }
            float gprev = __expf(lg);
#pragma unroll 1
            for (int seg = segb; seg < sege; ++seg) {
                const int tb = seg * 16;
                unsigned krraw[16];
#pragma unroll
                for (int i = 0; i < 16; ++i) krraw[i] = (unsigned)pk[(size_t)(tb + i) * NPJ] | ((unsigned)pr[(size_t)(tb + i) * NPJ] << 16);
#pragma unroll
                for (int i = 0; i < 16; ++i) {
                    const int t = tb + i, s = s0 + t;
                    const float lw = w0c + bf2f(sSCR[t * 64 + n]);
                    const float ee = 0.60653066f * frcp(1.f + __expf(-lw));
                    const float a = frcp(1.f + __expf(-(a0c + bf2f(sSCR[2048 + t * 64 + n]))));
                    const float kc = bflo(krraw[i]), rc = bfhi(krraw[i]);
                    const float ks = kc + (kp - kc) * muk, rs = rc + (rp - rc) * mur;
                    kp = kc; rp = rc;
                    const float kkv = ks * kkc;
                    const float ss = wave_sum_fast(kkv * kkv);
                    const float kk = kkv * rsqrtf(fmaxf(ss, 1e-24f));
                    const float kprime = ks * (1.f + (a - 1.f) * kac);
                    const float kka = kk * a;
                    const float bon = wave_sum_fast(rs * kprime * rkc);
                    const size_t rec = (size_t)bh * SEQ + s;
                    lg -= ee;
                    const float gcur = __expf(lg), ig = frcp(gcur);
                    p.KR[(rec * 4 + 0) * 64 + n] = f2bf(-gprev * kk); p.KR[(rec * 4 + 1) * 64 + n] = f2bf(kka * ig);
                    p.KR[(rec * 4 + 2) * 64 + n] = f2bf(kprime * ig); p.KR[(rec * 4 + 3) * 64 + n] = f2bf(rs * gcur);
                    if ((s & 63) == 63) p.GC[((size_t)bh * 64 + (s >> 6)) * 64 + n] = gcur;
                    if (n == 0) p.SBN[(size_t)(t0 + t) * NH + hd] = bon;
                    gprev = gcur;
                }
            }
            if (sege == 2) sLG[c] = lg;
        }
#define B1_LOAD(VV, BT) do { _Pragma("unroll") for (int i3 = 0; i3 < 3; ++i3) { const int it = (BT) * 3 + i3; \
            const int f = it * 512 + tid, fl = f & 63, dblk = (f >> 6) & 1, ks = (f >> 7) & 1, h = f >> 8, hh2 = fl >> 5, r2 = fl & 31; \
            _Pragma("unroll") for (int jp = 0; jp < 4; ++jp) { const int j0 = 2 * jp, j1 = 2 * jp + 1; \
                const int key0 = 16 * ks + 8 * (j0 >> 2) + 4 * hh2 + (j0 & 3), key1 = 16 * ks + 8 * (j1 >> 2) + 4 * hh2 + (j1 & 3); \
                const unsigned a0v = p.PJ[(size_t)(t0 + key0) * NPJ + C_AV + h * 64 + dblk * 32 + r2]; \
                const unsigned a1v = p.PJ[(size_t)(t0 + key1) * NPJ + C_AV + h * 64 + dblk * 32 + r2]; \
                VV[i3][jp] = a0v | (a1v << 16); } } } while (0)
#define B1_STORE(VV, BT) do { _Pragma("unroll") for (int i3 = 0; i3 < 3; ++i3) { const int it = (BT) * 3 + i3; \
            const int f = it * 512 + tid, fl = f & 63, dblk = (f >> 6) & 1, ks = (f >> 7) & 1, h = f >> 8; \
            uint4 o; o.x = VV[i3][0]; o.y = VV[i3][1]; o.z = VV[i3][2]; o.w = VV[i3][3]; \
            *(uint4*)(p.VF + ((((size_t)(b * NH + h) * 128 + (s0 >> 5)) * 2 + ks) * 2 + dblk) * 512 + fl * 8) = o; } } while (0)
#define B2_LOAD(UA, UB, BT) do { _Pragma("unroll") for (int i3 = 0; i3 < 3; ++i3) { const int it = (BT) * 3 + i3; \
            const int ridx = it * 128 + (tid >> 2), part = tid & 3; \
            const int which = ridx >= 384 ? 1 : 0, rr = ridx - which * 384, tok = rr / NH, h = rr - tok * NH; \
            const u16* ptr = p.PJ + (size_t)(t0 + tok) * NPJ + (which ? C_AK : C_AQ) + h * 64 + part * 16; \
            UA[i3] = *(const uint4*)ptr; UB[i3] = *(const uint4*)(ptr + 8); } } while (0)
        unsigned vvA[3][4], vvB[3][4]; uint4 uaA[3], ubA[3], uaB[3], ubB[3];
        {
            unsigned gate[2][8]; f32x16 zz[2]; float sc2[2];
#pragma unroll
            for (int ti = 0; ti < 2; ++ti) {
                const int tile = wave * 2 + ti, g = tile >> 2, ct = tile & 3, chn = g * 128 + 32 * ct + r;
                sc2[ti] = pool_scale[chn];
#pragma unroll
                for (int i = 0; i < 16; i += 2) gate[ti][i >> 1] = (unsigned)p.PJ[(size_t)(t0 + 8 * (i >> 2) + 4 * hh + (i & 3)) * NPJ + C_PG + chn] | ((unsigned)p.PJ[(size_t)(t0 + 8 * (i >> 2) + 4 * hh + (i & 3) + 1) * NPJ + C_PG + chn] << 16);
            }
            B1_LOAD(vvA, 0);
#pragma unroll
            for (int ti = 0; ti < 2; ++ti) {
                const int tile = wave * 2 + ti, g = tile >> 2, ct = tile & 3;
                f32x16 z = f16zero();
#pragma unroll
                for (int s = 0; s < 8; ++s) {
                    const bf16x8 a = *(const bf16x8*)(sD + r * DLD + g * 128 + 16 * s + 8 * hh);
                    const bf16x8 bq = *(const bf16x8*)(p.PWT + (size_t)(g * 128 + 32 * ct + r) * 128 + 16 * s + 8 * hh);
                    z = __builtin_amdgcn_mfma_f32_32x32x16_bf16(a, bq, z, 0, 0, 0);
                }
                zz[ti] = z;
            }
#pragma unroll
            for (int ti = 0; ti < 2; ++ti) {
                const int tile = wave * 2 + ti, g = tile >> 2, ct = tile & 3, chn = g * 128 + 32 * ct + r;
#pragma unroll
                for (int i = 0; i < 16; ++i) {
                    const size_t row = (size_t)(t0 + 8 * (i >> 2) + 4 * hh + (i & 3));
                    const float gt = (i & 1) ? bfhi(gate[ti][i >> 1]) : bflo(gate[ti][i >> 1]);
                    MIX[row * DM + 768 + chn] = f2bf(zz[ti][i] * sc2[ti] * silu(gt));
                }
            }
        }
        B1_STORE(vvA, 0);
        B1_LOAD(vvB, 1); B2_LOAD(uaA, ubA, 0);
        B1_STORE(vvB, 1);
        B2_LOAD(uaB, ubB, 1);
        {
#pragma unroll
            for (int i3 = 0; i3 < 3; ++i3) {
                const int it = 0 * 3 + i3;
                const int ridx = it * 128 + (tid >> 2), part = tid & 3;
                const int which = ridx >= 384 ? 1 : 0, rr = ridx - which * 384, tok = rr / NH, h = rr - tok * NH;
                u16* ptr = p.PJ + (size_t)(t0 + tok) * NPJ + (which ? C_AK : C_AQ) + h * 64 + part * 16;
                const uint4 u0 = uaA[i3], u1 = ubA[i3];
                float xv[16];
                xv[0] = bflo(u0.x); xv[1] = bfhi(u0.x); xv[2] = bflo(u0.y); xv[3] = bfhi(u0.y); xv[4] = bflo(u0.z); xv[5] = bfhi(u0.z); xv[6] = bflo(u0.w); xv[7] = bfhi(u0.w);
                xv[8] = bflo(u1.x); xv[9] = bfhi(u1.x); xv[10] = bflo(u1.y); xv[11] = bfhi(u1.y); xv[12] = bflo(u1.z); xv[13] = bfhi(u1.z); xv[14] = bflo(u1.w); xv[15] = bfhi(u1.w);
                float ss = 0.f;
#pragma unroll
                for (int i = 0; i < 16; ++i) ss += xv[i] * xv[i];
                ss += __shfl_xor(ss, 1); ss += __shfl_xor(ss, 2);
                const float inv = rsqrtf(ss * (1.f / 64.f) + 1e-6f) * (which ? 1.f : 0.125f * 1.44269504089f);
                const float* gg = (which ? kn_g : qn_g) + part * 16;
#pragma unroll
                for (int i = 0; i < 16; ++i) xv[i] = xv[i] * inv * gg[i];
                uint4 o0, o1;
                o0.x = pk2(xv[0], xv[1]); o0.y = pk2(xv[2], xv[3]); o0.z = pk2(xv[4], xv[5]); o0.w = pk2(xv[6], xv[7]);
                o1.x = pk2(xv[8], xv[9]); o1.y = pk2(xv[10], xv[11]); o1.z = pk2(xv[12], xv[13]); o1.w = pk2(xv[14], xv[15]);
                *(uint4*)ptr = o0; *(uint4*)(ptr + 8) = o1;
            }
        }
        {
#pragma unroll
            for (int i3 = 0; i3 < 3; ++i3) {
                const int it = 1 * 3 + i3;
                const int ridx = it * 128 + (tid >> 2), part = tid & 3;
                const int which = ridx >= 384 ? 1 : 0, rr = ridx - which * 384, tok = rr / NH, h = rr - tok * NH;
                u16* ptr = p.PJ + (size_t)(t0 + tok) * NPJ + (which ? C_AK : C_AQ) + h * 64 + part * 16;
                const uint4 u0 = uaB[i3], u1 = ubB[i3];
                float xv[16];
                xv[0] = bflo(u0.x); xv[1] = bfhi(u0.x); xv[2] = bflo(u0.y); xv[3] = bfhi(u0.y); xv[4] = bflo(u0.z); xv[5] = bfhi(u0.z); xv[6] = bflo(u0.w); xv[7] = bfhi(u0.w);
                xv[8] = bflo(u1.x); xv[9] = bfhi(u1.x); xv[10] = bflo(u1.y); xv[11] = bfhi(u1.y); xv[12] = bflo(u1.z); xv[13] = bfhi(u1.z); xv[14] = bflo(u1.w); xv[15] = bfhi(u1.w);
                float ss = 0.f;
#pragma unroll
                for (int i = 0; i < 16; ++i) ss += xv[i] * xv[i];
                ss += __shfl_xor(ss, 1); ss += __shfl_xor(ss, 2);
                const float inv = rsqrtf(ss * (1.f / 64.f) + 1e-6f) * (which ? 1.f : 0.125f * 1.44269504089f);
                const float* gg = (which ? kn_g : qn_g) + part * 16;
#pragma unroll
                for (int i = 0; i < 16; ++i) xv[i] = xv[i] * inv * gg[i];
                uint4 o0, o1;
                o0.x = pk2(xv[0], xv[1]); o0.y = pk2(xv[2], xv[3]); o0.z = pk2(xv[4], xv[5]); o0.w = pk2(xv[6], xv[7]);
                o1.x = pk2(xv[8], xv[9]); o1.y = pk2(xv[10], xv[11]); o1.z = pk2(xv[12], xv[13]); o1.w = pk2(xv[14], xv[15]);
                *(uint4*)ptr = o0; *(uint4*)(ptr + 8) = o1;
            }
        }
#undef B1_LOAD
#undef B1_STORE
#undef B2_LOAD
        __syncthreads();
    }
}

DI f32x16 mmnt(const u16* P, const u16* Q, int tr, int tc, int r, int hh, f32x16 acc) {
#pragma unroll
    for (int s = 0; s < 4; ++s) {
        const bf16x8 a = *(const bf16x8*)(P + (32 * tr + r) * ILD + 16 * s + 8 * hh);
        const bf16x8 b = *(const bf16x8*)(Q + (32 * tc + r) * ILD + 16 * s + 8 * hh);
        acc = __builtin_amdgcn_mfma_f32_32x32x16_bf16(a, b, acc, 0, 0, 0);
    }
    return acc;
}
DI void st_eff(u16* E, const f32x16& z, int tr, int tc, int r, int hh) {
#pragma unroll
    for (int g = 0; g < 4; ++g) { uint2 o; o.x = pk2(z[4 * g], z[4 * g + 1]); o.y = pk2(z[4 * g + 2], z[4 * g + 3]); *(uint2*)(E + (32 * tc + r) * ILD + 32 * tr + 8 * g + 4 * hh) = o; }
}
DI void st_scat(u16* F, const f32x16& z, int tr, int tc, int r, int hh) {
#pragma unroll
    for (int i = 0; i < 16; ++i) F[(32 * tr + 8 * (i >> 2) + 4 * hh + (i & 3)) * ILD + 32 * tc + r] = f2bf(z[i]);
}
#define SL(n) (img + (n) * IMG)
DI void rwkv_passA(const Params& p, int l, unsigned char* shm) {
    u16* img = (u16*)shm; float* gC = (float*)(shm + 16 * IMG * 2);
    const int tid = otid(), wave = __builtin_amdgcn_readfirstlane(tid >> 6), lane = tid & 63, r = lane & 31, hh = lane >> 5;
    const int grp = wave >> 2, tr = (wave >> 1) & 1, tc = wave & 1;
    const float* mu = p.mu_a + l * 3200;
    const int q = 32 * tc + r;
    uint4 sd0, sd1, sd2, sd3, scur, sprv, sga, sgp; float sgc = 0.f, ssb = 0.f;
    const float* gn_g = p.gn_g + l * 768; const float* gn_b = p.gn_b + l * 768;
    auto stage_load = [&](int cu2) __attribute__((always_inline)) {
        const int bh2 = cu2 >> 6, ch2 = cu2 & 63, b2 = bh2 / NH, h2 = bh2 - b2 * NH, t02 = ch2 * 64;
        const int a = tid >> 7, t = (tid >> 1) & 63, half = tid & 1;
        const u16* src = p.KR + (((size_t)bh2 * SEQ + t02 + t) * 4 + a) * 64 + half * 32;
        sd0 = *(const uint4*)(src); sd1 = *(const uint4*)(src + 8); sd2 = *(const uint4*)(src + 16); sd3 = *(const uint4*)(src + 24);
        const int tv = tid >> 3, vs = (tid & 7) * 8;
        const u16* pv = p.PJ + ((size_t)b2 * SEQ + t02 + tv) * NPJ + C_V + h2 * 64 + vs;
        scur = *(const uint4*)pv;
        sprv = make_uint4(0u, 0u, 0u, 0u); sgp = make_uint4(0u, 0u, 0u, 0u);
        sga = *(const uint4*)(pv + (C_G - C_V));
        if (t02 + tv > 0) { sprv = *(const uint4*)(pv - NPJ); sgp = *(const uint4*)(pv - NPJ + (C_G - C_V)); }
        ssb = p.SBN[((size_t)b2 * SEQ + t02 + tv) * NH + h2];
        if (tid < 64) sgc = p.GC[(size_t)cu2 * 64 + tid];
    };
    if (obid() < 48 * 64) stage_load(obid());
#pragma unroll 1
    for (int cu = obid(); cu < 48 * 64; cu += gridDim.x) {
        const int bh = cu >> 6, ch = cu & 63, b = bh / NH, h = bh - b * NH, t0 = ch * 64;
        {
            const int a = tid >> 7, t = (tid >> 1) & 63, half = tid & 1;
            const uint4 d[4] = {sd0, sd1, sd2, sd3};
            u16* dst = SL(a) + t * ILD + half * 32;
#pragma unroll
            for (int j = 0; j < 4; ++j) *(uint4*)(dst + 8 * j) = d[j];
            if (a < 3) {
                u16* dT = SL(4 + a) + (half * 32) * ILD + t;
#pragma unroll
                for (int j = 0; j < 4; ++j) {
                    const unsigned w4[4] = {d[j].x, d[j].y, d[j].z, d[j].w};
#pragma unroll
                    for (int e = 0; e < 4; ++e) { dT[(8 * j + 2 * e) * ILD] = (u16)(w4[e] & 0xffffu); dT[(8 * j + 2 * e + 1) * ILD] = (u16)(w4[e] >> 16); }
                }
            }
            const int tv = tid >> 3, vs = (tid & 7) * 8;
            const unsigned cw[4] = {scur.x, scur.y, scur.z, scur.w}, pw[4] = {sprv.x, sprv.y, sprv.z, sprv.w};
            u16* vT = SL(7) + vs * ILD + tv;
            const unsigned gw[4] = {sga.x, sga.y, sga.z, sga.w}, gq[4] = {sgp.x, sgp.y, sgp.z, sgp.w};
            unsigned a1o[4], a2o[4];
#pragma unroll
            for (int e = 0; e < 4; ++e) {
                const int ch0 = h * 64 + vs + 2 * e;
                const float c0 = bflo(cw[e]), c1 = bfhi(cw[e]), p0 = bflo(pw[e]), p1 = bfhi(pw[e]);
                const float v0 = c0 + (p0 - c0) * mu[C_V + ch0], v1 = c1 + (p1 - c1) * mu[C_V + ch0 + 1];
                vT[(2 * e) * ILD] = f2bf(v0);
                vT[(2 * e + 1) * ILD] = f2bf(v1);
                const float g0 = bflo(gw[e]), g1 = bfhi(gw[e]), q0 = bflo(gq[e]), q1 = bfhi(gq[e]);
                const float sl0 = silu(g0 + (q0 - g0) * mu[C_G + ch0]), sl1 = silu(g1 + (q1 - g1) * mu[C_G + ch0 + 1]);
                a1o[e] = pk2(gn_g[ch0] * sl0, gn_g[ch0 + 1] * sl1);
                a2o[e] = pk2((gn_b[ch0] + ssb * v0) * sl0, (gn_b[ch0 + 1] + ssb * v1) * sl1);
            }
            *(uint4*)(p.HB + ((size_t)b * SEQ + t0 + tv) * DM + h * 64 + vs) = make_uint4(a1o[0], a1o[1], a1o[2], a1o[3]);
            *(uint4*)(p.PJ + ((size_t)b * SEQ + t0 + tv) * NPJ + C_K + h * 64 + vs) = make_uint4(a2o[0], a2o[1], a2o[2], a2o[3]);
            if (tid < 64) gC[tid] = sgc;
        }
        if (cu + (int)gridDim.x < 48 * 64) stage_load(cu + gridDim.x);
        __syncthreads();
        if (grp == 0) {
            f32x16 z = mmnt(SL(0), SL(1), tr, tc, r, hh, f16zero());
            f32x16 tt;
#pragma unroll
            for (int i = 0; i < 16; ++i) { const int pp = 32 * tr + 8 * (i >> 2) + 4 * hh + (i & 3); z[i] = (q < pp) ? z[i] : 0.f; tt[i] = z[i] + ((q == pp) ? 1.f : 0.f); }
            st_eff(SL(9), z, tr, tc, r, hh); st_scat(SL(8), z, tr, tc, r, hh); st_eff(SL(12), tt, tr, tc, r, hh);
        } else {
            f32x16 z = mmnt(SL(2), SL(0), tr, tc, r, hh, f16zero());
#pragma unroll
            for (int i = 0; i < 16; ++i) { const int pp = 32 * tr + 8 * (i >> 2) + 4 * hh + (i & 3); z[i] = (pp < q) ? z[i] : 0.f; }
            st_eff(SL(14), z, tr, tc, r, hh);
        }
        __syncthreads();
        if (grp == 0) { const f32x16 z = mmnt(SL(8), SL(9), tr, tc, r, hh, f16zero()); st_eff(SL(11), z, tr, tc, r, hh); st_scat(SL(10), z, tr, tc, r, hh); }
        else { const f32x16 z = mmnt(SL(14), SL(7), tr, tc, r, hh, f16zero()); st_eff(SL(15), z, tr, tc, r, hh); }
        __syncthreads();
#pragma unroll 1
        for (int m = 0; m < 4; ++m) {
            const int even = (m & 1) == 0;
            u16* Lr = even ? SL(10) : SL(8); u16* Ltr = even ? SL(11) : SL(9); u16* Lw = even ? SL(8) : SL(10); u16* Ltw = even ? SL(9) : SL(11);
            u16* TTr = even ? SL(12) : SL(13); u16* TTw = even ? SL(13) : SL(12);
            if (grp == 0) { const f32x16 z = mmnt(Lr, Ltr, tr, tc, r, hh, f16zero()); st_eff(Ltw, z, tr, tc, r, hh); st_scat(Lw, z, tr, tc, r, hh); }
            else {
                f32x16 z = mmnt(Lr, TTr, tr, tc, r, hh, f16zero());
#pragma unroll
                for (int g = 0; g < 4; ++g) { const uint2 o = *(const uint2*)(TTr + q * ILD + 32 * tr + 8 * g + 4 * hh); z[4 * g] += bflo(o.x); z[4 * g + 1] += bfhi(o.x); z[4 * g + 2] += bflo(o.y); z[4 * g + 3] += bfhi(o.y); }
                st_eff(TTw, z, tr, tc, r, hh);
            }
            __syncthreads();
        }
        if (grp == 1) {
            f32x16 z = mmnt(SL(10), SL(12), tr, tc, r, hh, f16zero());
#pragma unroll
            for (int g = 0; g < 4; ++g) { const uint2 o = *(const uint2*)(SL(12) + q * ILD + 32 * tr + 8 * g + 4 * hh); z[4 * g] += bflo(o.x); z[4 * g + 1] += bfhi(o.x); z[4 * g + 2] += bflo(o.y); z[4 * g + 3] += bfhi(o.y); }
            st_scat(SL(0), z, tr, tc, r, hh);
        } else {
            f32x16 z = mmnt(SL(1), SL(3), tr, tc, r, hh, f16zero());
#pragma unroll
            for (int i = 0; i < 16; ++i) { const int pp = 32 * tr + 8 * (i >> 2) + 4 * hh + (i & 3); z[i] = (pp <= q) ? z[i] : 0.f; }
            st_eff(SL(14), z, tr, tc, r, hh);
            z = mmnt(SL(2), SL(3), tr, tc, r, hh, f16zero());
#pragma unroll
            for (int i = 0; i < 16; ++i) { const int pp = 32 * tr + 8 * (i >> 2) + 4 * hh + (i & 3); z[i] = (pp <= q) ? z[i] : 0.f; }
            st_eff(SL(8), z, tr, tc, r, hh);
        }
        __syncthreads();
        if (grp == 0) { const f32x16 z = mmnt(SL(0), SL(15), tr, tc, r, hh, f16zero()); st_eff(SL(9), z, tr, tc, r, hh); }
        else { const f32x16 z = mmnt(SL(0), SL(4), tr, tc, r, hh, f16zero()); st_eff(SL(10), z, tr, tc, r, hh); }
        __syncthreads();
        const size_t tokq = (size_t)bh * SEQ + t0 + q;
        if (grp == 0) {
            f32x16 z = mmnt(SL(10), SL(5), tr, tc, r, hh, f16zero());
            const float gq = gC[q];
            u16* gt = p.GH + (size_t)cu * 8192 + q * 64 + 32 * tr + 4 * hh;
#pragma unroll
            for (int g = 0; g < 4; ++g) { uint2 o; o.x = pk2(z[4 * g] * gq, z[4 * g + 1] * gq); o.y = pk2(z[4 * g + 2] * gq, z[4 * g + 3] * gq); *(uint2*)(gt + 8 * g) = o; }
            z = mmnt(SL(10), SL(14), tr, tc, r, hh, f16zero());
            u16* rp = p.KR + (tokq * 4 + 3) * 64 + 32 * tr + 4 * hh;
#pragma unroll
            for (int g = 0; g < 4; ++g) {
                const uint2 o = *(const uint2*)(SL(3) + q * ILD + 32 * tr + 8 * g + 4 * hh);
                uint2 w; w.x = pk2(z[4 * g] + bflo(o.x), z[4 * g + 1] + bfhi(o.x)); w.y = pk2(z[4 * g + 2] + bflo(o.y), z[4 * g + 3] + bfhi(o.y));
                *(uint2*)(rp + 8 * g) = w;
            }
        } else {
            f32x16 z = mmnt(SL(5), SL(9), tr, tc, r, hh, f16zero());
            z = mmnt(SL(6), SL(7), tr, tc, r, hh, z);
            u16* hp = p.GH + (size_t)cu * 8192 + 4096 + q * 64 + 32 * tr + 4 * hh;
#pragma unroll
            for (int g = 0; g < 4; ++g) {
                const float4 gg = *(const float4*)(gC + 32 * tr + 8 * g + 4 * hh);
                uint2 o; o.x = pk2(z[4 * g] * gg.x, z[4 * g + 1] * gg.y); o.y = pk2(z[4 * g + 2] * gg.z, z[4 * g + 3] * gg.w);
                *(uint2*)(hp + 8 * g) = o;
            }
            z = mmnt(SL(9), SL(14), tr, tc, r, hh, f16zero());
            z = mmnt(SL(7), SL(8), tr, tc, r, hh, z);
            u16* yp = p.PJ + ((size_t)b * SEQ + t0 + q) * NPJ + C_PU + h * 64 + 32 * tr + 4 * hh;
#pragma unroll
            for (int g = 0; g < 4; ++g) { uint2 o; o.x = pk2(z[4 * g], z[4 * g + 1]); o.y = pk2(z[4 * g + 2], z[4 * g + 3]); *(uint2*)(yp + 8 * g) = o; }
        }
        __syncthreads();
    }
}

DI void rwkv_passB(const Params& p, unsigned char* shm) {
    u16* img = (u16*)shm;
    constexpr int RS = 4 * IMG + 128;
    u16* ring = img + 4 * IMG;
    const int tid = otid(), wave = __builtin_amdgcn_readfirstlane(tid >> 6), lane = tid & 63, r = lane & 31, hh = lane >> 5;
    const int bh = obid(), b = bh / NH, h = bh - b * NH;
    if (wave >= 4) {
        const int lt = tid - 256;
        auto ld = [&](int jj, int chn) __attribute__((always_inline)) -> uint4 {
            const size_t cu = (size_t)bh * 64 + chn; const int t0 = chn * 64;
            const int idx = lt + 256 * (jj & 1), row = idx >> 3, c8 = idx & 7; const u16* src;
            if ((jj >> 1) == 0) src = p.GH + cu * 8192 + row * 64 + c8 * 8;
            else if ((jj >> 1) == 1) src = p.KR + (((size_t)bh * SEQ + t0 + row) * 4 + 3) * 64 + c8 * 8;
            else if ((jj >> 1) == 2) src = p.GH + cu * 8192 + 4096 + row * 64 + c8 * 8;
            else if ((jj >> 1) == 3) src = p.PJ + ((size_t)b * SEQ + t0 + row) * NPJ + C_PU + h * 64 + c8 * 8;
            else if ((jj >> 1) == 4) src = p.HB + ((size_t)b * SEQ + t0 + row) * DM + h * 64 + c8 * 8;
            else src = p.PJ + ((size_t)b * SEQ + t0 + row) * NPJ + C_K + h * 64 + c8 * 8;
            return *(const uint4*)src;
        };
        auto stp = [&](int jj, int slot, const uint4& v) __attribute__((always_inline)) {
            const int idx = lt + 256 * (jj & 1), row = idx >> 3, c8 = idx & 7;
            *(uint4*)(ring + slot * RS + (jj >> 1) * IMG + row * ILD + c8 * 8) = v;
        };
        auto ldg = [&](int chn) __attribute__((always_inline)) -> float4 { float4 g = make_float4(0.f, 0.f, 0.f, 0.f); if (lt < 16) g = *(const float4*)(p.GC + ((size_t)bh * 64 + chn) * 64 + lt * 4); return g; };
        auto stg = [&](int slot, const float4& g) __attribute__((always_inline)) { if (lt < 16) *(float4*)((float*)(ring + slot * RS + 4 * IMG) + lt * 4) = g; };
        auto emit = [&](int chn, int j2, const uint4& a1, const uint4& a2) __attribute__((always_inline)) {
            const int idx = lt + 256 * j2, row = idx >> 3, c8 = idx & 7;
            const uint4 nv = *(const uint4*)(img + (2 + (chn & 1)) * IMG + row * ILD + c8 * 8);
            const unsigned nn[4] = {nv.x, nv.y, nv.z, nv.w}, x1[4] = {a1.x, a1.y, a1.z, a1.w}, x2[4] = {a2.x, a2.y, a2.z, a2.w};
            unsigned o[4];
#pragma unroll
            for (int e = 0; e < 4; ++e) o[e] = pk2(bflo(nn[e]) * bflo(x1[e]) + bflo(x2[e]), bfhi(nn[e]) * bfhi(x1[e]) + bfhi(x2[e]));
            *(uint4*)(p.HB + ((size_t)b * SEQ + chn * 64 + row) * DM + h * 64 + c8 * 8) = make_uint4(o[0], o[1], o[2], o[3]);
        };
#define PB_DECL(S) uint4 a##S##0, a##S##1, a##S##2, a##S##3, a##S##4, a##S##5, a##S##6, a##S##7; float4 g##S
#define PB_ISSUE(S, CH) do { a##S##0 = ld(0, CH); a##S##1 = ld(1, CH); a##S##2 = ld(2, CH); a##S##3 = ld(3, CH); a##S##4 = ld(4, CH); a##S##5 = ld(5, CH); a##S##6 = ld(6, CH); a##S##7 = ld(7, CH); g##S = ldg(CH); } while (0)
#define PB_WRITE(S, SLOT) do { stp(0, SLOT, a##S##0); stp(1, SLOT, a##S##1); stp(2, SLOT, a##S##2); stp(3, SLOT, a##S##3); stp(4, SLOT, a##S##4); stp(5, SLOT, a##S##5); stp(6, SLOT, a##S##6); stp(7, SLOT, a##S##7); stg(SLOT, g##S); } while (0)
#define PA_DECL(S) uint4 f##S##0, f##S##1, f##S##2, f##S##3
#define PA_ISSUE(S, CH) do { f##S##0 = ld(8, CH); f##S##1 = ld(9, CH); f##S##2 = ld(10, CH); f##S##3 = ld(11, CH); } while (0)
#define PA_EMIT(S, CH) do { emit(CH, 0, f##S##0, f##S##2); emit(CH, 1, f##S##1, f##S##3); } while (0)
        PB_DECL(0); PB_DECL(1);
        PA_DECL(0); PA_DECL(1); PA_DECL(2); PA_DECL(3); PA_DECL(4); PA_DECL(5);
        PB_ISSUE(0, 0); PB_ISSUE(1, 1);
        PA_ISSUE(0, 0); PA_ISSUE(1, 1); PA_ISSUE(2, 2); PA_ISSUE(3, 3);
        PB_WRITE(0, 0); PB_ISSUE(0, 2);
        PB_WRITE(1, 1); PB_ISSUE(1, 3);
        __syncthreads();
#define PB_STEP(U, RSET, SLOT, AEM, AIS) do { const int st = c6 + (U); if (st < 64) { \
            if (st + 2 < 64) { PB_WRITE(RSET, SLOT); if (st + 4 < 64) PB_ISSUE(RSET, st + 4); } \
            if (st >= 1) PA_EMIT(AEM, st - 1); \
            if (st + 4 < 64) PA_ISSUE(AIS, st + 4); \
            __syncthreads(); } } while (0)
#pragma unroll 1
        for (int c6 = 0; c6 < 66; c6 += 6) {
            PB_STEP(0, 0, 2, 5, 4); PB_STEP(1, 1, 0, 0, 5); PB_STEP(2, 0, 1, 1, 0); PB_STEP(3, 1, 2, 2, 1); PB_STEP(4, 0, 0, 3, 2); PB_STEP(5, 1, 1, 4, 3);
        }
        PA_EMIT(3, 63);
#undef PB_STEP
#undef PB_DECL
#undef PB_ISSUE
#undef PB_WRITE
#undef PA_DECL
#undef PA_ISSUE
#undef PA_EMIT
        return;
    }
    if (wave >= 2) {
        const int tr = wave - 2;
        f32x16 S0 = f16zero(), S1 = f16zero();
        st_eff(SL(0), S0, tr, 0, r, hh); st_eff(SL(0), S1, tr, 1, r, hh);
        __syncthreads();
#pragma unroll 1
        for (int ch = 0; ch < 64; ++ch) {
            const u16* Si = SL(ch & 1);
            const u16* rs = ring + (ch % 3) * RS;
            const u16 *GTi = rs, *Hi = rs + 2 * IMG; const float* gCi = (const float*)(rs + 4 * IMG);
            f32x16 z0 = f16zero(), z1 = f16zero();
#pragma unroll
            for (int s = 0; s < 4; ++s) {
                const bf16x8 ga = *(const bf16x8*)(GTi + (32 * tr + r) * ILD + 16 * s + 8 * hh);
                const bf16x8 sb0 = *(const bf16x8*)(Si + r * ILD + 16 * s + 8 * hh), sb1 = *(const bf16x8*)(Si + (32 + r) * ILD + 16 * s + 8 * hh);
                z0 = __builtin_amdgcn_mfma_f32_32x32x16_bf16(ga, sb0, z0, 0, 0, 0);
                z1 = __builtin_amdgcn_mfma_f32_32x32x16_bf16(ga, sb1, z1, 0, 0, 0);
            }
#pragma unroll
            for (int g = 0; g < 4; ++g) {
                const float4 gg = *(const float4*)(gCi + 32 * tr + 8 * g + 4 * hh);
                const uint2 h0 = *(const uint2*)(Hi + r * ILD + 32 * tr + 8 * g + 4 * hh), h1 = *(const uint2*)(Hi + (32 + r) * ILD + 32 * tr + 8 * g + 4 * hh);
                S0[4 * g] = S0[4 * g] * gg.x + z0[4 * g] + bflo(h0.x); S0[4 * g + 1] = S0[4 * g + 1] * gg.y + z0[4 * g + 1] + bfhi(h0.x);
                S0[4 * g + 2] = S0[4 * g + 2] * gg.z + z0[4 * g + 2] + bflo(h0.y); S0[4 * g + 3] = S0[4 * g + 3] * gg.w + z0[4 * g + 3] + bfhi(h0.y);
                S1[4 * g] = S1[4 * g] * gg.x + z1[4 * g] + bflo(h1.x); S1[4 * g + 1] = S1[4 * g + 1] * gg.y + z1[4 * g + 1] + bfhi(h1.x);
                S1[4 * g + 2] = S1[4 * g + 2] * gg.z + z1[4 * g + 2] + bflo(h1.y); S1[4 * g + 3] = S1[4 * g + 3] * gg.w + z1[4 * g + 3] + bfhi(h1.y);
            }
            st_eff(SL((ch + 1) & 1), S0, tr, 0, r, hh); st_eff(SL((ch + 1) & 1), S1, tr, 1, r, hh);
            __syncthreads();
        }
        return;
    }
    {
        const int tc = wave, q = 32 * tc + r;
        __syncthreads();
#pragma unroll 1
        for (int ch = 0; ch < 64; ++ch) {
            const u16* Si = SL(ch & 1);
            const u16* rs = ring + (ch % 3) * RS;
            const u16 *RPi = rs + IMG, *YVi = rs + 3 * IMG;
            u16* Ni = img + (2 + (ch & 1)) * IMG;
            f32x16 z0 = f16zero(), z1 = f16zero();
#pragma unroll
            for (int s = 0; s < 4; ++s) {
                const bf16x8 rb = *(const bf16x8*)(RPi + q * ILD + 16 * s + 8 * hh);
                const bf16x8 sa0 = *(const bf16x8*)(Si + r * ILD + 16 * s + 8 * hh), sa1 = *(const bf16x8*)(Si + (32 + r) * ILD + 16 * s + 8 * hh);
                z0 = __builtin_amdgcn_mfma_f32_32x32x16_bf16(sa0, rb, z0, 0, 0, 0);
                z1 = __builtin_amdgcn_mfma_f32_32x32x16_bf16(sa1, rb, z1, 0, 0, 0);
            }
            float s1 = 0.f, s2 = 0.f;
#pragma unroll
            for (int g = 0; g < 4; ++g) {
                const uint2 y0 = *(const uint2*)(YVi + q * ILD + 8 * g + 4 * hh), y1 = *(const uint2*)(YVi + q * ILD + 32 + 8 * g + 4 * hh);
                z0[4 * g] += bflo(y0.x); z0[4 * g + 1] += bfhi(y0.x); z0[4 * g + 2] += bflo(y0.y); z0[4 * g + 3] += bfhi(y0.y);
                z1[4 * g] += bflo(y1.x); z1[4 * g + 1] += bfhi(y1.x); z1[4 * g + 2] += bflo(y1.y); z1[4 * g + 3] += bfhi(y1.y);
#pragma unroll
                for (int e = 0; e < 4; ++e) { s1 += z0[4 * g + e] + z1[4 * g + e]; s2 += z0[4 * g + e] * z0[4 * g + e] + z1[4 * g + e] * z1[4 * g + e]; }
            }
            s1 += __shfl_xor(s1, 32); s2 += __shfl_xor(s2, 32);
            const float mean = s1 * (1.f / 64.f);
            const float rstd = rsqrtf(fmaxf(s2 * (1.f / 64.f) - mean * mean, 0.f) + 64e-5f);
#pragma unroll
            for (int g = 0; g < 4; ++g) {
                uint2 o0, o1;
                o0.x = pk2((z0[4 * g] - mean) * rstd, (z0[4 * g + 1] - mean) * rstd); o0.y = pk2((z0[4 * g + 2] - mean) * rstd, (z0[4 * g + 3] - mean) * rstd);
                o1.x = pk2((z1[4 * g] - mean) * rstd, (z1[4 * g + 1] - mean) * rstd); o1.y = pk2((z1[4 * g + 2] - mean) * rstd, (z1[4 * g + 3] - mean) * rstd);
                *(uint2*)(Ni + q * ILD + 8 * g + 4 * hh) = o0; *(uint2*)(Ni + q * ILD + 32 + 8 * g + 4 * hh) = o1;
            }
            __syncthreads();
        }
    }
}
#undef SL

DI void attn_unit(const Params& p, int unit) {
    const int lane = otid() & 63, r = lane & 31, hh = lane >> 5;
    const int bh = unit >> 7, qt = unit & 127, b = bh / NH, h = bh - b * NH;
    const int q0 = qt * 32, qrow = q0 + r;
    const u16* pjb = p.PJ + (size_t)b * SEQ * NPJ;
    bf16x8 qf[4];
#pragma unroll
    for (int ks = 0; ks < 4; ++ks) qf[ks] = *(const bf16x8*)(pjb + (size_t)(q0 + r) * NPJ + C_AQ + h * 64 + ks * 16 + hh * 8);
    f32x16 O0, O1;
#pragma unroll
    for (int i = 0; i < 16; ++i) { O0[i] = 0.f; O1[i] = 0.f; }
    float carry = 0.f;
    bf16x8 kf[4], v00, v01, v10, v11;
#define AT_LOAD(KF, V00, V01, V10, V11, KT) do { const int _k0 = (KT) * 32; \
        _Pragma("unroll") for (int ks = 0; ks < 4; ++ks) KF[ks] = *(const bf16x8*)(pjb + (size_t)(_k0 + r) * NPJ + C_AK + h * 64 + ks * 16 + hh * 8); \
        const u16* _vfp = p.VF + (((size_t)bh * 128 + (KT)) * 4) * 512 + lane * 8; \
        V00 = *(const bf16x8*)(_vfp); V01 = *(const bf16x8*)(_vfp + 512); V10 = *(const bf16x8*)(_vfp + 1024); V11 = *(const bf16x8*)(_vfp + 1536); } while (0)
    AT_LOAD(kf, v00, v01, v10, v11, qt);
    bf16x8 kf2[4], w00, w01, w10, w11;
    if (qt > 0) AT_LOAD(kf2, w00, w01, w10, w11, qt - 1);
    const u16* gp = p.PJ + ((size_t)b * SEQ + q0 + r) * NPJ + C_AG + h * 64;
    uint2 gu[8];
#pragma unroll
    for (int i = 0; i < 8; ++i) gu[i] = *(const uint2*)(gp + (i >> 2) * 32 + 8 * (i & 3) + 4 * hh);
#pragma unroll 1
    for (int kt = qt; kt >= 0; --kt) {
        const int k0 = kt * 32;
        bf16x8 kf3[4], x00, x01, x10, x11;
        if (kt > 1) AT_LOAD(kf3, x00, x01, x10, x11, kt - 2);
        f32x16 z;
#pragma unroll
        for (int i = 0; i < 16; ++i) z[i] = 0.f;
#pragma unroll
        for (int ks = 0; ks < 4; ++ks) z = __builtin_amdgcn_mfma_f32_32x32x16_bf16(kf[ks], qf[ks], z, 0, 0, 0);
        float l1m[16], lb[16];
#pragma unroll
        for (int i = 0; i < 16; ++i) {
            const int key = k0 + (i & 3) + 8 * (i >> 2) + 4 * hh;
            const float zz = z[i];
            const float sp = fmaxf(zz, 0.f) + __builtin_amdgcn_logf(1.f + __builtin_amdgcn_exp2f(-fabsf(zz)));
            l1m[i] = (key < qrow) ? -sp : 0.f;
            lb[i] = (key < qrow) ? (zz - sp) : -1e30f;
        }
        float Gs[4], Gp[4];
#pragma unroll
        for (int g = 0; g < 4; ++g) { Gs[g] = (l1m[4 * g] + l1m[4 * g + 1]) + (l1m[4 * g + 2] + l1m[4 * g + 3]); Gp[g] = __shfl_xor(Gs[g], 32); }
        float E[4];
        const float keep = hh ? 0.f : 1.f;
        E[3] = keep * Gp[3];
        E[2] = Gs[3] + Gp[3] + keep * Gp[2];
        E[1] = Gs[3] + Gs[2] + Gp[3] + Gp[2] + keep * Gp[1];
        E[0] = Gs[3] + Gs[2] + Gs[1] + Gp[3] + Gp[2] + Gp[1] + keep * Gp[0];
        float w[16];
#pragma unroll
        for (int g = 0; g < 4; ++g) {
            float a = carry + E[g];
            w[4 * g + 3] = __builtin_amdgcn_exp2f(lb[4 * g + 3] + a); a += l1m[4 * g + 3];
            w[4 * g + 2] = __builtin_amdgcn_exp2f(lb[4 * g + 2] + a); a += l1m[4 * g + 2];
            w[4 * g + 1] = __builtin_amdgcn_exp2f(lb[4 * g + 1] + a); a += l1m[4 * g + 1];
            w[4 * g + 0] = __builtin_amdgcn_exp2f(lb[4 * g + 0] + a);
        }
        carry += (Gs[0] + Gs[1]) + (Gs[2] + Gs[3]) + (Gp[0] + Gp[1]) + (Gp[2] + Gp[3]);
        union { unsigned u[4]; bf16x8 v; } x0, x1;
#pragma unroll
        for (int j = 0; j < 4; ++j) { x0.u[j] = pk2(w[2 * j], w[2 * j + 1]); x1.u[j] = pk2(w[8 + 2 * j], w[8 + 2 * j + 1]); }
        O0 = __builtin_amdgcn_mfma_f32_32x32x16_bf16(v00, x0.v, O0, 0, 0, 0);
        O1 = __builtin_amdgcn_mfma_f32_32x32x16_bf16(v01, x0.v, O1, 0, 0, 0);
        O0 = __builtin_amdgcn_mfma_f32_32x32x16_bf16(v10, x1.v, O0, 0, 0, 0);
        O1 = __builtin_amdgcn_mfma_f32_32x32x16_bf16(v11, x1.v, O1, 0, 0, 0);
        if (__all(carry < -150.f)) break;
        if (kt > 0) {
#pragma unroll
            for (int ks = 0; ks < 4; ++ks) { kf[ks] = kf2[ks]; kf2[ks] = kf3[ks]; }
            v00 = w00; v01 = w01; v10 = w10; v11 = w11;
            w00 = x00; w01 = x01; w10 = x10; w11 = x11;
        }
    }
#undef AT_LOAD
    const size_t row = (size_t)b * SEQ + q0 + r;
    u16* mp = p.HB + row * DM + 1280 + h * 64;
#pragma unroll
    for (int dblk = 0; dblk < 2; ++dblk)
#pragma unroll
        for (int g = 0; g < 4; ++g) {
            const int d = dblk * 32 + 8 * g + 4 * hh;
            const uint2 gv = gu[dblk * 4 + g];
            const float o0 = dblk ? O1[4 * g + 0] : O0[4 * g + 0], o1 = dblk ? O1[4 * g + 1] : O0[4 * g + 1], o2 = dblk ? O1[4 * g + 2] : O0[4 * g + 2], o3 = dblk ? O1[4 * g + 3] : O0[4 * g + 3];
            uint2 o; o.x = pk2(o0 * silu(bflo(gv.x)), o1 * silu(bfhi(gv.x))); o.y = pk2(o2 * silu(bflo(gv.y)), o3 * silu(bfhi(gv.y)));
            *(uint2*)(mp + d) = o;
        }
}

DI void phase_p4b(const Params& p, int l, unsigned char* shm) {
    constexpr int NB = 48, UA = 6144;
    const int wave = __builtin_amdgcn_readfirstlane(otid() >> 6);
    if (obid() < NB) {
        rwkv_passB(p, shm);
        for (int u = UA + obid() * 8 + wave; u < 48 * 128; u += NB * 8) attn_unit(p, u);
        return;
    }
    for (int u = (obid() - NB) * 8 + wave; u < UA; u += (gridDim.x - NB) * 8) attn_unit(p, u);
    if (l == 0) { __syncthreads(); convert_weights(p, 1, shm, obid() - NB, gridDim.x - NB, 0, 32 * (NPJ / 256)); }
}

DI void run_phase(const Params& p, int ph, int l, unsigned char* shm) {
    switch (ph) {
    case 0: phase_p1(p, l, shm); break;
    case 1: { pg8::Gemm g{p.HB, p.W1, MTOK, NG1, DM}; pg8::StaticOrder S; S.init(MTOK, NG1, gridDim.x, obid()); pg8::EpiBf16 E{p.PJ, NPJ};
              pg8::gemm_phase<pg8::EpiBf16, pg8::StaticOrder>((PG8_LAS unsigned char*)shm, g, S, E); } break;
    case 2: phase_p3(p, l, shm); break;
    case 3: rwkv_passA(p, l, shm); break;
    case 4: phase_p4b(p, l, shm); break;
    case 6: { pg8::Gemm g{p.HB, p.W2, MTOK, DM, DM}; pg8::StaticOrder S; S.init(MTOK, DM, gridDim.x, obid()); pg8::EpiRes E{l == 0 ? p.x : p.out, p.out, DM};
              pg8::gemm_phase<pg8::EpiRes, pg8::StaticOrder>((PG8_LAS unsigned char*)shm, g, S, E); } break;
    }
}

#if MK_COOP
__global__ __launch_bounds__(512, 2) void mk_fwd(Params p, int ph_lo, int ph_hi) {
    extern __shared__ __attribute__((aligned(16))) unsigned char shm[];
    volatile LAS unsigned* st = (volatile LAS unsigned*)((LAS unsigned char*)shm + 148 * 1024);
    if (threadIdx.x < 2) st[threadIdx.x] = 0u;
    __syncthreads();
    const XcdBarrier xb = xcd_barrier_post(p.BAR, st);
    if (p.x == nullptr) cg::this_grid().sync();
#pragma unroll 1
    for (int l = 0; l < 2; ++l) {
        run_phase(p, 0, l, shm); xcd_barrier(xb);
        run_phase(p, 1, l, shm); xcd_barrier(xb);
        run_phase(p, 2, l, shm); xcd_barrier(xb);
        run_phase(p, 3, l, shm); xcd_barrier(xb);
        run_phase(p, 4, l, shm); xcd_barrier(xb);
        run_phase(p, 6, l, shm); if (l == 0) xcd_barrier(xb);
    }
}
#define MK_KERNEL mk_fwd
#else
template <int PH> __global__ __launch_bounds__(512, 2) void k_ph(Params p, int l) {
    extern __shared__ __attribute__((aligned(16))) unsigned char shm[];
    run_phase(p, PH, l, shm);
}
#define MK_KERNEL k_ph<1>
#endif

extern "C" void kernel_launch(void* const* d_in, const int* in_sizes, int n_in, void* d_out, int out_size, void* d_ws, size_t ws_size, hipStream_t stream) {
    static int grid = 0;
    if (grid == 0) {
        int dev = 0, cus = 0, per_cu = 0;
        (void)hipGetDevice(&dev); (void)hipDeviceGetAttribute(&cus, hipDeviceAttributeMultiprocessorCount, dev);
#if MK_COOP
        if (hipFuncSetAttribute((const void*)mk_fwd, hipFuncAttributeMaxDynamicSharedMemorySize, LDS_BYTES) != hipSuccess) { fprintf(stderr, "kernel_launch: hipFuncSetAttribute failed\n"); grid = -1; return; }
#else
        (void)hipFuncSetAttribute((const void*)k_ph<0>, hipFuncAttributeMaxDynamicSharedMemorySize, LDS_BYTES); (void)hipFuncSetAttribute((const void*)k_ph<1>, hipFuncAttributeMaxDynamicSharedMemorySize, LDS_BYTES);
        (void)hipFuncSetAttribute((const void*)k_ph<2>, hipFuncAttributeMaxDynamicSharedMemorySize, LDS_BYTES); (void)hipFuncSetAttribute((const void*)k_ph<3>, hipFuncAttributeMaxDynamicSharedMemorySize, LDS_BYTES);
        (void)hipFuncSetAttribute((const void*)k_ph<4>, hipFuncAttributeMaxDynamicSharedMemorySize, LDS_BYTES); (void)hipFuncSetAttribute((const void*)k_ph<5>, hipFuncAttributeMaxDynamicSharedMemorySize, LDS_BYTES);
        (void)hipFuncSetAttribute((const void*)k_ph<6>, hipFuncAttributeMaxDynamicSharedMemorySize, LDS_BYTES);
#endif
        if (hipOccupancyMaxActiveBlocksPerMultiprocessor(&per_cu, (const void*)MK_KERNEL, 512, LDS_BYTES) != hipSuccess || per_cu < 1) { fprintf(stderr, "kernel_launch: occupancy query gave %d\n", per_cu); per_cu = 1; }
        (void)hipGetLastError();
        grid = cus * per_cu;
    }
    if (grid < 0) return;
    Params p{};
    const float* const* in = (const float* const*)d_in;
    p.x = in[0]; p.norm_g = in[1]; p.w_in = in[2]; p.mu_a = in[3]; p.w_up = in[4]; p.w0 = in[5]; p.a_up = in[6]; p.a0 = in[7]; p.k_k = in[8]; p.k_a = in[9]; p.r_k = in[10];
    p.gn_g = in[11]; p.gn_b = in[12]; p.pool_w = in[13]; p.pool_scale = in[14]; p.qn_g = in[15]; p.kn_g = in[16]; p.w_out = in[17];
    p.out = (float*)d_out;
    unsigned char* ws = (unsigned char*)d_ws; size_t off = 0;
    auto take = [&](size_t bytes) { unsigned char* q = ws + off; off += (bytes + 255) & ~(size_t)255; return q; };
    p.W1 = (u16*)take((size_t)NPJ * DM * 2); p.W2 = (u16*)take((size_t)DM * DM * 2); p.HB = (u16*)take((size_t)MTOK * DM * 2); p.PJ = (u16*)take((size_t)MTOK * NPJ * 2);
    p.KR = (u16*)take((size_t)48 * SEQ * 256 * 2); p.VF = (u16*)take((size_t)48 * SEQ * 64 * 2); p.GH = (u16*)take((size_t)48 * 64 * 8192 * 2);
    p.WUT = (u16*)take(768 * 64 * 2); p.AUT = (u16*)take(768 * 64 * 2); p.PWT = (u16*)take(4 * 128 * 128 * 2);
    p.GC = (float*)take((size_t)48 * 64 * 64 * 4); p.SBN = (float*)take((size_t)MTOK * NH * 4); p.BAR = (unsigned*)take(XCD_BAR_WORDS * 4);
    if (off > ws_size) { fprintf(stderr, "kernel_launch: workspace too small: need %zu, have %zu\n", off, ws_size); return; }
    if (hipMemsetAsync(p.BAR, 0, XCD_BAR_WORDS * 4, stream) != hipSuccess) { fprintf(stderr, "kernel_launch: memset of the barrier words failed\n"); return; }
#if MK_COOP
    int lo = 0, hi = 12;
    void* args[] = {&p, &lo, &hi};
    hipError_t e = hipLaunchCooperativeKernel((const void*)mk_fwd, dim3(grid), dim3(512), args, LDS_BYTES, stream);
    if (e != hipSuccess) fprintf(stderr, "cooperative launch failed: %s (grid %d)\n", hipGetErrorString(e), grid);
#else
    for (int l = 0; l < 2; ++l) {
        hipLaunchKernelGGL(k_ph<0>, dim3(grid), dim3(512), LDS_BYTES, stream, p, l);
        hipLaunchKernelGGL(k_ph<1>, dim3(grid), dim3(512), LDS_BYTES, stream, p, l);
        hipLaunchKernelGGL(k_ph<2>, dim3(grid), dim3(512), LDS_BYTES, stream, p, l);
        hipLaunchKernelGGL(k_ph<3>, dim3(grid), dim3(512), LDS_BYTES, stream, p, l);
        hipLaunchKernelGGL(k_ph<4>, dim3(grid), dim3(512), LDS_BYTES, stream, p, l);
        hipLaunchKernelGGL(k_ph<5>, dim3(grid), dim3(512), LDS_BYTES, stream, p, l);
        hipLaunchKernelGGL(k_ph<6>, dim3(grid), dim3(512), LDS_BYTES, stream, p, l);
    }
#endif
}
```

```cpp
#include <hip/hip_runtime.h>
#include <hip/hip_cooperative_groups.h>
#include <cstdio>
namespace cg = cooperative_groups;
__device__ __forceinline__ int otid() { int t = threadIdx.x; asm volatile("" : "+v"(t)); return t; }
__device__ __forceinline__ int obid() { int b = blockIdx.x; asm volatile("" : "+s"(b)); return b; }
#ifndef MK_COOP
#define MK_COOP 1
#endif
namespace pg8 {
#define PG8_LAS __attribute__((address_space(3)))
typedef unsigned short bf16_t;
typedef short bf16x8 __attribute__((ext_vector_type(8)));
typedef float f32x4 __attribute__((ext_vector_type(4)));
typedef unsigned u32x4 __attribute__((ext_vector_type(4)));
constexpr int BM = 256, BK = 64, HALF = 128, HTB = HALF * BK * 2  , STAGE_BYTES = 8 * HTB, NXCD = 8, WGM = 8;

__host__ __device__ __forceinline__ int lds_byte(int r, int c) { const int st = (r >> 4) * 2 + (c >> 5), rr = r & 15, cc = c & 31, ob = rr * 64 + cc * 2; return st * 1024 + (ob ^ (((ob >> 9) & 1) << 5)); }
__host__ __device__ __forceinline__ void stage_rc(int b, int& R, int& C) { const int st = b / 1024, sb = b % 1024, swz = sb ^ (((sb >> 9) & 1) << 5); R = (st >> 1) * 16 + swz / 64; C = (st & 1) * 32 + (swz % 64) / 2; }
__host__ __device__ __forceinline__ int perm32(int rho) { const int n = rho >> 4, i = rho & 15; return 8 * (i >> 2) + 4 * n + (i & 3); }

struct Unit { int pm, pn; };
struct Gemm { const bf16_t* A; const bf16_t* Bt; int M, N, K; };
struct StaticOrder {
    int nM, nN, nwg, G, c;
    __host__ __device__ void init(int M, int N, int G_, int c_) { nM = M / BM; nN = N / BM; nwg = nM * nN; G = G_; c = c_; }
    __host__ __device__ bool next(int i, Unit& u) const {
        const long L = (long)i * G + c; if (L >= nwg) return false;
        int wgid = (int)L; { const int q = nwg / NXCD, r = nwg % NXCD, xcd = wgid % NXCD, off = wgid / NXCD; wgid = (xcd < r ? xcd * (q + 1) : r * (q + 1) + (xcd - r) * q) + off; }
        const int nig = WGM * nN, gid = wgid / nig, fm = gid * WGM, gsz = (nM - fm) < WGM ? (nM - fm) : WGM;
        u.pm = fm + ((wgid % nig) % gsz); u.pn = (wgid % nig) / gsz; return true;
    }
    __device__ __forceinline__ void a_ready(const Unit&) const {}
    __device__ __forceinline__ void done(const Unit&) const {}
};
__device__ __forceinline__ unsigned cvt_pk_bf16(float lo, float hi) { unsigned r; asm volatile("v_cvt_pk_bf16_f32 %0, %1, %2" : "=v"(r) : "v"(lo), "v"(hi)); return r; }
struct EpiBf16 {
    static constexpr bool PERM = true, AFTER_DRAIN = false;
    bf16_t* O; int ldc;
    __device__ __forceinline__ void operator()(const f32x4 (&acc)[2][2][4][2], const Unit& u, int wr, int wc, int fr, int fq) const {
        const int row0 = u.pm * BM + wr * 64 + fr; const int col0 = u.pn * BM + wc * 32 + 8 * fq;
#pragma unroll
        for (int ai = 0; ai < 2; ++ai)
#pragma unroll
            for (int m = 0; m < 4; ++m) { bf16_t* rowp = O + (size_t)(row0 + ai * HALF + m * 16) * ldc + col0;
#pragma unroll
                for (int bj = 0; bj < 2; ++bj) { const f32x4 v0 = acc[ai][bj][m][0], v1 = acc[ai][bj][m][1];
                    u32x4 w; w.x = cvt_pk_bf16(v0[0], v0[1]); w.y = cvt_pk_bf16(v0[2], v0[3]); w.z = cvt_pk_bf16(v1[0], v1[1]); w.w = cvt_pk_bf16(v1[2], v1[3]);
                    *(u32x4*)(rowp + bj * HALF) = w; } }
    }
};
struct EpiRes {
    static constexpr bool PERM = false, AFTER_DRAIN = false;
    const float* R; float* C; int ldc; int nt;
    __device__ __forceinline__ void operator()(const f32x4 (&acc)[2][2][4][2], const Unit& u, int wr, int wc, int fr, int fq) const {
        const int row0 = u.pm * BM + wr * 64 + fr, col0 = u.pn * BM + wc * 32 + 4 * fq;
#pragma unroll
        for (int ai = 0; ai < 2; ++ai)
#pragma unroll
            for (int mp = 0; mp < 2; ++mp) {
                f32x4 rr[2][2][2];
#pragma unroll
                for (int mm = 0; mm < 2; ++mm) { const size_t off = (size_t)(row0 + ai * HALF + (2 * mp + mm) * 16) * ldc + col0;
#pragma unroll
                    for (int bj = 0; bj < 2; ++bj)
#pragma unroll
                        for (int n = 0; n < 2; ++n) rr[mm][bj][n] = *(const f32x4*)(R + off + bj * HALF + n * 16); }
#pragma unroll
                for (int mm = 0; mm < 2; ++mm) { const size_t off = (size_t)(row0 + ai * HALF + (2 * mp + mm) * 16) * ldc + col0;
#pragma unroll
                    for (int bj = 0; bj < 2; ++bj)
#pragma unroll
                        for (int n = 0; n < 2; ++n) { const f32x4 o = acc[ai][bj][2 * mp + mm][n] + rr[mm][bj][n]; f32x4* dp = (f32x4*)(C + off + bj * HALF + n * 16);
                            if (nt) __builtin_nontemporal_store(o, dp); else *dp = o; } }
            }
    }
};
template <class Epi, class Sched>
__device__ __forceinline__ void gemm_phase(PG8_LAS unsigned char* lds, const Gemm g, const Sched& S, const Epi& E) {
    const int tid = otid(), wid = __builtin_amdgcn_readfirstlane(tid >> 6), lane = tid & 63, wr = wid >> 2, wc = wid & 3, fr = lane & 15, fq = lane >> 4;
    const int K = g.K, nt = K / BK;
    unsigned voffA[2], voffB[2];
#pragma unroll
    for (int i = 0; i < 2; ++i) { int R, C; stage_rc(tid * 16 + i * 8192, R, C); const int Rb = Epi::PERM ? ((R & ~31) + perm32(R & 31)) : R;
        voffA[i] = (unsigned)(R * K + C) * 2u; voffB[i] = (unsigned)(Rb * K + C) * 2u; }
    const size_t kstep = (size_t)(BK * 2);
    const size_t hstep = (size_t)HALF * K * 2;
    const size_t tstep = 2 * hstep;
    const unsigned ldsw = (unsigned)wid * 1024u;
    const int aoff = lds_byte(wr * 64 + fr, fq * 8), boff = lds_byte(wc * 32 + fr, fq * 8);
#define PG8_SA(b, h) (((b) * 2 + (h)) * HTB)
#define PG8_SB(b, h) ((4 + (b) * 2 + (h)) * HTB)
#define PG8_STAGE(bufoff, gbase, voff) do { _Pragma("unroll") for (int _i = 0; _i < 2; ++_i) \
        __builtin_amdgcn_global_load_lds((const unsigned*)((const char*)(gbase) + (voff)[_i]), (PG8_LAS unsigned*)(lds + (bufoff) + ldsw + _i * 8192), 16, 0, 0); } while (0)
#define PG8_LDA(dst, b, h) do { _Pragma("unroll") for (int m = 0; m < 4; ++m) _Pragma("unroll") for (int k = 0; k < 2; ++k) dst[m][k] = *(const PG8_LAS bf16x8*)(lds + PG8_SA(b, h) + aoff + m * 2048 + k * 1024); } while (0)
#define PG8_LDB(dst, b, h) do { _Pragma("unroll") for (int n = 0; n < 2; ++n) _Pragma("unroll") for (int k = 0; k < 2; ++k) dst[n][k] = *(const PG8_LAS bf16x8*)(lds + PG8_SB(b, h) + boff + n * 2048 + k * 1024); } while (0)
#define PG8_MMA(ai, bj, At, Bt) do { __builtin_amdgcn_s_setprio(1); _Pragma("unroll") for (int m = 0; m < 4; ++m) _Pragma("unroll") for (int n = 0; n < 2; ++n) _Pragma("unroll") for (int k = 0; k < 2; ++k) \
        acc[ai][bj][m][n] = __builtin_amdgcn_mfma_f32_16x16x32_bf16(Bt[n][k], At[m][k], acc[ai][bj][m][n], 0, 0, 0); __builtin_amdgcn_s_setprio(0); } while (0)
#define PG8_WAIT_V(n) asm volatile("s_waitcnt vmcnt(" #n ")" ::: "memory")
#define PG8_WAIT_L(n) asm volatile("s_waitcnt lgkmcnt(" #n ")" ::: "memory")
#define PG8_BAR __builtin_amdgcn_s_barrier()
#define PG8_SCHED __builtin_amdgcn_sched_barrier(0)
    Unit cur, nxt; int ui = 0;
    if (!S.next(0, cur)) return;
    f32x4 acc[2][2][4][2];
#pragma unroll
    for (int a = 0; a < 2; ++a)
#pragma unroll
        for (int b = 0; b < 2; ++b)
#pragma unroll
            for (int m = 0; m < 4; ++m)
#pragma unroll
                for (int n = 0; n < 2; ++n) acc[a][b][m][n] = (f32x4){0.f, 0.f, 0.f, 0.f};
    bf16x8 At[4][2], B0[2][2], B1[2][2];
    const char* cA = (const char*)g.A + (size_t)cur.pm * tstep; const char* cB = (const char*)g.Bt + (size_t)cur.pn * tstep;
    S.a_ready(cur);
    PG8_STAGE(PG8_SB(0, 0), cB, voffB); PG8_STAGE(PG8_SA(0, 0), cA, voffA); PG8_STAGE(PG8_SB(0, 1), cB + hstep, voffB); PG8_STAGE(PG8_SA(0, 1), cA + hstep, voffA);
    if (wr == 1) PG8_BAR;
    PG8_WAIT_V(4); PG8_BAR;
    PG8_STAGE(PG8_SB(1, 0), cB + kstep, voffB); PG8_STAGE(PG8_SA(1, 0), cA + kstep, voffA); PG8_STAGE(PG8_SB(1, 1), cB + hstep + kstep, voffB);
    PG8_WAIT_V(6); PG8_BAR;
    for (;;) {
        const bool has_next = S.next(ui + 1, nxt);
        const char* nA = has_next ? (const char*)g.A + (size_t)nxt.pm * tstep : cA; const char* nB = has_next ? (const char*)g.Bt + (size_t)nxt.pn * tstep : cB;
        for (int t = 0; t < nt; t += 2) {
            const bool last = (t == nt - 2);
            const char* a1 = cA + (size_t)(t + 1) * kstep;
            const char* a2 = last ? nA : cA + (size_t)(t + 2) * kstep; const char* b2 = last ? nB : cB + (size_t)(t + 2) * kstep;
            const char* a3 = a2 + kstep; const char* b3 = b2 + kstep;
            if (last && has_next) S.a_ready(nxt);
            PG8_LDB(B0, 0, 0); PG8_SCHED; PG8_LDA(At, 0, 0); PG8_STAGE(PG8_SA(1, 1), a1 + hstep, voffA);
            PG8_WAIT_L(8); PG8_BAR; PG8_WAIT_L(0); PG8_MMA(0, 0, At, B0); PG8_BAR; PG8_SCHED;
            PG8_LDB(B1, 0, 1); PG8_STAGE(PG8_SB(0, 0), b2, voffB);
            PG8_BAR; PG8_WAIT_L(0); PG8_MMA(0, 1, At, B1); PG8_BAR;
            PG8_LDA(At, 0, 1); PG8_STAGE(PG8_SA(0, 0), a2, voffA);
            PG8_BAR; PG8_WAIT_L(0); PG8_MMA(1, 0, At, B0); PG8_BAR; PG8_SCHED;
            PG8_STAGE(PG8_SB(0, 1), b2 + hstep, voffB);
            PG8_WAIT_V(6); PG8_BAR; PG8_MMA(1, 1, At, B1); PG8_BAR;
            PG8_LDB(B0, 1, 0); PG8_SCHED; PG8_LDA(At, 1, 0); PG8_STAGE(PG8_SA(0, 1), a2 + hstep, voffA);
            PG8_WAIT_L(8); PG8_BAR; PG8_WAIT_L(0); PG8_MMA(0, 0, At, B0); PG8_BAR; PG8_SCHED;
            PG8_LDB(B1, 1, 1); PG8_STAGE(PG8_SB(1, 0), b3, voffB);
            PG8_BAR; PG8_WAIT_L(0); PG8_MMA(0, 1, At, B1); PG8_BAR;
            PG8_LDA(At, 1, 1); PG8_STAGE(PG8_SA(1, 0), a3, voffA);
            PG8_BAR; PG8_WAIT_L(0); PG8_MMA(1, 0, At, B0); PG8_BAR; PG8_SCHED;
            PG8_STAGE(PG8_SB(1, 1), b3 + hstep, voffB);
            PG8_WAIT_V(6); PG8_BAR; PG8_MMA(1, 1, At, B1); PG8_BAR;
        }
        if constexpr (!Epi::AFTER_DRAIN) { E(acc, cur, wr, wc, fr, fq); S.done(cur); }
        if (!has_next) break;
#pragma unroll
        for (int a = 0; a < 2; ++a)
#pragma unroll
            for (int b = 0; b < 2; ++b)
#pragma unroll
                for (int m = 0; m < 4; ++m)
#pragma unroll
                    for (int n = 0; n < 2; ++n) acc[a][b][m][n] = (f32x4){0.f, 0.f, 0.f, 0.f};
        cur = nxt; cA = nA; cB = nB; ++ui;
    }
    PG8_WAIT_V(0);
    if (wr == 0) PG8_BAR;
    PG8_BAR;
    if constexpr (Epi::AFTER_DRAIN) { E.fused(acc, cur, wr, wc, fr, fq, lds, wid, lane); S.done(cur); }
#undef PG8_SA
#undef PG8_SB
#undef PG8_STAGE
#undef PG8_LDA
#undef PG8_LDB
#undef PG8_MMA
#undef PG8_WAIT_V
#undef PG8_WAIT_L
#undef PG8_BAR
#undef PG8_SCHED
}
}
#define XB_TMO      128
#define XB_XCNT(j)  (256  + 64 * (j))
#define XB_XSUB(j)  (1280 + 64 * (j))
#define XB_XGEN(j)  (2304 + 64 * (j))
#define XB_TOP      3328
#define XB_TOPGEN   3392
#define XCD_BAR_WORDS 3456
#define XB_SPIN_CAP (1u << 18)
#define LAS __attribute__((address_space(3)))

__device__ __forceinline__ unsigned xb_ld(unsigned* p)              { return __hip_atomic_load(p, __ATOMIC_RELAXED, __HIP_MEMORY_SCOPE_AGENT); }
__device__ __forceinline__ unsigned xb_add(unsigned* p, unsigned v) { return __hip_atomic_fetch_add(p, v, __ATOMIC_RELAXED, __HIP_MEMORY_SCOPE_AGENT); }
__device__ __forceinline__ unsigned xb_xcc_id() { return (unsigned)__builtin_amdgcn_s_getreg((3 << 11) | 20) & 0xFu; }
#define XB_SPIN(cond, bar) do { unsigned _sp = 0; while (cond) { __builtin_amdgcn_s_sleep(1); \
    if ((++_sp & 255u) == 0u) { if (xb_ld(&(bar)[XB_TMO])) break; if (_sp > XB_SPIN_CAP) { atomicAdd(&(bar)[XB_TMO], 1u); break; } } } } while (0)
struct XcdBarrier {
    unsigned* bar; unsigned x;
    volatile LAS unsigned* st;
};

__device__ __forceinline__ XcdBarrier xcd_barrier_post(unsigned* bar, volatile LAS unsigned* st) {
    XcdBarrier b; b.bar = bar; b.x = xb_xcc_id(); b.st = st;
    if (threadIdx.x == 0) (void)xb_add(&bar[XB_XCNT(b.x)], 1u);
    return b;
}
__device__ __forceinline__ void xcd_barrier_complete(unsigned* bar, unsigned x, unsigned& nloc, unsigned& nx) {
    const unsigned G = gridDim.x * gridDim.y * gridDim.z;
    unsigned sum, cnt, mine, sp = 0u;
    for (;;) {
        sum = 0u; cnt = 0u; mine = 0u;
#pragma unroll
        for (unsigned j = 0; j < 16; ++j) { const unsigned c = xb_ld(&bar[XB_XCNT(j)]); sum += c; cnt += (c > 0u) ? 1u : 0u; mine = (j == x) ? c : mine; }
        if (sum == G) break;
        __builtin_amdgcn_s_sleep(1);
        if ((++sp & 255u) == 0u) { if (xb_ld(&bar[XB_TMO])) break; if (sp > XB_SPIN_CAP) { atomicAdd(&bar[XB_TMO], 1u); break; } }
    }
    nloc = mine > 0u ? mine : 1u; nx = cnt > 0u ? cnt : 1u;
}

__device__ __forceinline__ void xcd_barrier(const XcdBarrier& b) {
    asm volatile("s_waitcnt vmcnt(0)" ::: "memory");
    __syncthreads();
    if (threadIdx.x == 0) {
        unsigned* bar = b.bar;
        __builtin_amdgcn_s_waitcnt(0);
        unsigned nloc = b.st[0], nx = b.st[1];
        if (nloc == 0u) { xcd_barrier_complete(bar, b.x, nloc, nx); b.st[0] = nloc; b.st[1] = nx; }
        const unsigned old = xb_add(&bar[XB_XSUB(b.x)], 1u);
        const unsigned gen = old / nloc;
        if (old + 1u == (gen + 1u) * nloc) {
            __builtin_amdgcn_fence(__ATOMIC_RELEASE, "agent");
            asm volatile("s_waitcnt vmcnt(0)" ::: "memory");
            const unsigned og = xb_add(&bar[XB_TOP], 1u);
            const unsigned tg = og / nx;
            if (og + 1u == (tg + 1u) * nx) xb_add(&bar[XB_TOPGEN], 1u);
            else XB_SPIN(xb_ld(&bar[XB_TOPGEN]) == tg, bar);
            __builtin_amdgcn_fence(__ATOMIC_ACQUIRE, "agent");
            xb_add(&bar[XB_XGEN(b.x)], 1u);
            asm volatile("s_waitcnt vmcnt(0)" ::: "memory");
        } else {
            XB_SPIN(xb_ld(&bar[XB_XGEN(b.x)]) == gen, bar);
            __builtin_amdgcn_fence(__ATOMIC_ACQUIRE, "agent");
            asm volatile("s_waitcnt vmcnt(0)" ::: "memory");
        }
    }
    __syncthreads();
}

typedef unsigned short u16;
typedef short bf16x8 __attribute__((ext_vector_type(8)));
typedef float f32x16 __attribute__((ext_vector_type(16)));
#define DI __device__ __forceinline__
constexpr int MTOK = 16384, SEQ = 4096, DM = 2048, NPJ = 7424, NIN = 7296, NH = 12, NG1 = 7168;
constexpr int C_R = 0, C_K = 768, C_V = 1536, C_G = 2304, C_WD = 3072, C_PU = 3200, C_PG = 3712, C_AQ = 4224, C_AK = 4992, C_AV = 5760, C_AG = 6528;
constexpr int LDS_BYTES = 148 * 1024 + 64;

struct Params {
    const float *x, *norm_g, *w_in, *mu_a, *w_up, *w0, *a_up, *a0, *k_k, *k_a, *r_k, *gn_g, *gn_b, *pool_w, *pool_scale, *qn_g, *kn_g, *w_out;
    float* out;
    u16 *W1, *W2, *HB, *PJ, *KR, *VF, *GH, *WUT, *AUT, *PWT;
    float *GC, *SBN;
    unsigned* BAR;
};

DI float bf2f(u16 b) { return __uint_as_float(((unsigned)b) << 16); }
typedef __bf16 hwbf16x2 __attribute__((ext_vector_type(2)));
typedef float hwf32x2 __attribute__((ext_vector_type(2)));
DI unsigned pk2(float lo, float hi) { const hwf32x2 f = {lo, hi}; return __builtin_bit_cast(unsigned, __builtin_convertvector(f, hwbf16x2)); }
DI u16 f2bf(float f) { return (u16)(pk2(f, 0.f) & 0xffffu); }
DI float bflo(unsigned u) { return __uint_as_float(u << 16); }
DI float bfhi(unsigned u) { return __uint_as_float(u & 0xffff0000u); }
DI float silu(float x) { return x / (1.f + __expf(-x)); }
DI float wave_sum(float v) {
#pragma unroll
    for (int o = 32; o > 0; o >>= 1) v += __shfl_xor(v, o);
    return v;
}
template <int CTRL> DI float dpp_mov(float x) { return __builtin_bit_cast(float, __builtin_amdgcn_update_dpp(0, __builtin_bit_cast(int, x), CTRL, 0xf, 0xf, false)); }
DI float row16_sum(float x) {
    x += dpp_mov<0xB1>(x); x += dpp_mov<0x4E>(x); x += dpp_mov<0x141>(x); x += dpp_mov<0x140>(x); return x;
}

constexpr int ILD = 72, IMG = 64 * ILD;
DI f32x16 f16zero() { f32x16 z;
#pragma unroll
    for (int i = 0; i < 16; ++i) z[i] = 0.f; return z; }

DI void convert_weights(const Params& p, int l, unsigned char* shm, int u0, int ustride, int ubeg, int uend) {
    const int tid = otid();
    float* sT = (float*)shm;
    const float* win = p.w_in + (size_t)l * DM * NIN;
    const float* wout = p.w_out + (size_t)l * DM * DM;
    const int nW1 = 32 * (NPJ / 256);
    float4 v0, v1, v2, v3, v4, v5, v6, v7;
    auto ldv = [&](int u, int i) __attribute__((always_inline)) -> float4 {
        const float* src; int N, kt, nt;
        if (u < nW1) { kt = u & 31; nt = u >> 5; src = win; N = NIN; } else { const int w2 = u - nW1; kt = w2 & 31; nt = w2 >> 5; src = wout; N = DM; }
        const int kk = (tid >> 6) + 8 * i, nn = (tid & 63) * 4;
        float4 r = make_float4(0.f, 0.f, 0.f, 0.f);
        if (nt * 256 + nn < N) r = *(const float4*)(src + (size_t)(kt * 64 + kk) * N + nt * 256 + nn);
        return r;
    };
#define CW_LOAD(U) do { v0 = ldv(U, 0); v1 = ldv(U, 1); v2 = ldv(U, 2); v3 = ldv(U, 3); v4 = ldv(U, 4); v5 = ldv(U, 5); v6 = ldv(U, 6); v7 = ldv(U, 7); } while (0)
#define CW_PARK(I, V) do { const int kk = (tid >> 6) + 8 * (I), nn = (tid & 63) * 4; sT[kk * 257 + nn + 0] = V.x; sT[kk * 257 + nn + 1] = V.y; sT[kk * 257 + nn + 2] = V.z; sT[kk * 257 + nn + 3] = V.w; } while (0)
    if (ubeg + u0 < uend) CW_LOAD(ubeg + u0);
    for (int u = ubeg + u0; u < uend; u += ustride) {
        u16* dst; int kt, nt;
        if (u < nW1) { kt = u & 31; nt = u >> 5; dst = p.W1; } else { const int w2 = u - nW1; kt = w2 & 31; nt = w2 >> 5; dst = p.W2; }
        const int k0 = kt * 64, n0 = nt * 256;
        CW_PARK(0, v0); CW_PARK(1, v1); CW_PARK(2, v2); CW_PARK(3, v3); CW_PARK(4, v4); CW_PARK(5, v5); CW_PARK(6, v6); CW_PARK(7, v7);
        __syncthreads();
        if (u + ustride < uend) CW_LOAD(u + ustride);
        {
            const int nn = tid >> 1, ks = (tid & 1) * 32;
#pragma unroll
            for (int c4 = 0; c4 < 4; ++c4) {
                const int kb = ks + c4 * 8;
                uint4 o;
                o.x = pk2(sT[(kb + 0) * 257 + nn], sT[(kb + 1) * 257 + nn]); o.y = pk2(sT[(kb + 2) * 257 + nn], sT[(kb + 3) * 257 + nn]);
                o.z = pk2(sT[(kb + 4) * 257 + nn], sT[(kb + 5) * 257 + nn]); o.w = pk2(sT[(kb + 6) * 257 + nn], sT[(kb + 7) * 257 + nn]);
                *(uint4*)(dst + (size_t)(n0 + nn) * DM + k0 + kb) = o;
            }
        }
        __syncthreads();
    }
#undef CW_LOAD
#undef CW_PARK
}

DI void phase_p1(const Params& p, int l, unsigned char* shm) {
    const int tid = otid(), wave = tid >> 6, lane = tid & 63;
    const int nW1 = 32 * (NPJ / 256), nW2 = 32 * (DM / 256);
    const float* xin = l == 0 ? p.x : p.out;
    const float* g = p.norm_g + l * DM;
    float4 gq[8];
#pragma unroll
    for (int i = 0; i < 8; ++i) gq[i] = *(const float4*)(g + i * 256 + lane * 4);
    const int rstep = gridDim.x * 16;
    int row = (obid() * 8 + wave) * 2;
    float4 v[16];
    if (row < MTOK) {
#pragma unroll
        for (int i = 0; i < 16; ++i) v[i] = *(const float4*)(xin + (size_t)(row + (i >> 3)) * DM + (i & 7) * 256 + lane * 4);
    }
    convert_weights(p, l, shm, obid(), gridDim.x, l == 0 ? 0 : nW1, nW1 + nW2);
    {
        const float* w_up = p.w_up + l * 64 * 768; const float* a_up = p.a_up + l * 64 * 768; const float* pool_w = p.pool_w + (size_t)l * 4 * 128 * 128;
        for (int e = obid() * 512 + tid; e < 768 * 64; e += gridDim.x * 512) { const int c = e >> 6, j = e & 63; p.WUT[e] = f2bf(w_up[j * 768 + c]); p.AUT[e] = f2bf(a_up[j * 768 + c]); }
        for (int e = obid() * 512 + tid; e < 4 * 128 * 128; e += gridDim.x * 512) { const int g2 = e >> 14, dd = (e >> 7) & 127, c = e & 127; p.PWT[e] = f2bf(pool_w[(g2 * 128 + c) * 128 + dd]); }
    }
#pragma unroll 1
    for (; row < MTOK; row += rstep) {
        float4 vn[16];
        const int rown = row + rstep;
        if (rown < MTOK) {
#pragma unroll
            for (int i = 0; i < 16; ++i) vn[i] = *(const float4*)(xin + (size_t)(rown + (i >> 3)) * DM + (i & 7) * 256 + lane * 4);
        }
        float ss0 = 0.f, ss1 = 0.f;
#pragma unroll
        for (int i = 0; i < 8; ++i) { ss0 += v[i].x * v[i].x + v[i].y * v[i].y + v[i].z * v[i].z + v[i].w * v[i].w; ss1 += v[8 + i].x * v[8 + i].x + v[8 + i].y * v[8 + i].y + v[8 + i].z * v[8 + i].z + v[8 + i].w * v[8 + i].w; }
        ss0 = wave_sum(ss0); ss1 = wave_sum(ss1);
        const float inv0 = rsqrtf(ss0 * (1.f / DM) + 1e-6f), inv1 = rsqrtf(ss1 * (1.f / DM) + 1e-6f);
#pragma unroll
        for (int i = 0; i < 16; ++i) {
            const float inv = (i < 8) ? inv0 : inv1;
            const float4 gg = gq[i & 7];
            uint2 o; o.x = pk2(v[i].x * inv * gg.x, v[i].y * inv * gg.y); o.y = pk2(v[i].z * inv * gg.z, v[i].w * inv * gg.w);
            *(uint2*)(p.HB + (size_t)(row + (i >> 3)) * DM + (i & 7) * 256 + lane * 4) = o;
        }
        if (rown < MTOK) {
#pragma unroll
            for (int i = 0; i < 16; ++i) v[i] = vn[i];
        }
    }
}

DI float wave_sum_fast(float x) {
    const int xi = __builtin_bit_cast(int, row16_sum(x));
    const float s0 = __builtin_bit_cast(float, __builtin_amdgcn_readlane(xi, 0)), s1 = __builtin_bit_cast(float, __builtin_amdgcn_readlane(xi, 16));
    const float s2 = __builtin_bit_cast(float, __builtin_amdgcn_readlane(xi, 32)), s3 = __builtin_bit_cast(float, __builtin_amdgcn_readlane(xi, 48));
    return (s0 + s1) + (s2 + s3);
}
DI float frcp(float x) { return __builtin_amdgcn_rcpf(x); }
DI void phase_p3(const Params& p, int l, unsigned char* shm) {
    const float* mu = p.mu_a + l * 3200;
    const float* w0 = p.w0 + l * 768; const float* a0 = p.a0 + l * 768; const float* k_k = p.k_k + l * 768; const float* k_a = p.k_a + l * 768; const float* r_k = p.r_k + l * 768;
    const float* pool_scale = p.pool_scale + l * 512;
    const float* qn_g = p.qn_g + l * 64; const float* kn_g = p.kn_g + l * 64;
    constexpr int DLD = 520;
    u16* sXW = (u16*)shm;
    u16* sXA = sXW + 32 * ILD;
    u16* sD = sXA + 32 * ILD;
    float* sLG = (float*)(sD + 32 * DLD);
    u16* sRAW = (u16*)(sLG + 768);
    u16* MIX = p.HB;
    for (int unit2 = obid() * 2; unit2 < MTOK / 32; unit2 += gridDim.x * 2)
    for (int sub = 0; sub < 2; ++sub) {
        if (sub == 0) {
            const int tid = otid(), wave = __builtin_amdgcn_readfirstlane(tid >> 6), lane = tid & 63, r = lane & 31, hh = lane >> 5;
            constexpr int TLD = 136;
            u16* sTA = (u16*)shm; u16* sTB = sTA + 64 * TLD;
            const int trw = wave >> 2, tcw = wave & 3;
            auto t0_src = [&](int jj, int kc) __attribute__((always_inline)) -> const u16* {
                const int idx = tid + 512 * (jj < 2 ? jj : jj - 2), row = idx >> 4, c16 = idx & 15;
                return (jj < 2) ? p.HB + (size_t)(unit2 * 32 + row) * DM + kc * 128 + c16 * 8 : p.W1 + (size_t)(NG1 + row) * DM + kc * 128 + c16 * 8;
            };
            constexpr int TBUF = 192 * TLD;
            auto t0_dst = [&](int jj, int buf) __attribute__((always_inline)) -> u16* {
                const int idx = tid + 512 * (jj < 2 ? jj : jj - 2), row = idx >> 4, c16 = idx & 15;
                return ((jj < 2) ? sTA : sTB) + buf * TBUF + row * TLD + c16 * 8;
            };
            uint4 pf0, pf1, pf2, pf3, pf4, pf5;
#define T0_ISSUE(KC) do { pf0 = *(const uint4*)t0_src(0, KC); pf1 = *(const uint4*)t0_src(1, KC); pf2 = *(const uint4*)t0_src(2, KC); pf3 = *(const uint4*)t0_src(3, KC); pf4 = *(const uint4*)t0_src(4, KC); pf5 = *(const uint4*)t0_src(5, KC); } while (0)
#define T0_PARK(BUF) do { *(uint4*)t0_dst(0, BUF) = pf0; *(uint4*)t0_dst(1, BUF) = pf1; *(uint4*)t0_dst(2, BUF) = pf2; *(uint4*)t0_dst(3, BUF) = pf3; *(uint4*)t0_dst(4, BUF) = pf4; *(uint4*)t0_dst(5, BUF) = pf5; } while (0)
            T0_ISSUE(0);
            T0_PARK(0);
            T0_ISSUE(1);
            __syncthreads();
            f32x16 z = f16zero();
#pragma unroll 1
            for (int kc = 0; kc < 16; ++kc) {
                const u16* cA = sTA + (kc & 1) * TBUF; const u16* cB = sTB + (kc & 1) * TBUF;
#pragma unroll 4
                for (int s = 0; s < 8; ++s) {
                    const bf16x8 a = *(const bf16x8*)(cA + (32 * trw + r) * TLD + 16 * s + 8 * hh), bq = *(const bf16x8*)(cB + (32 * tcw + r) * TLD + 16 * s + 8 * hh);
                    z = __builtin_amdgcn_mfma_f32_32x32x16_bf16(a, bq, z, 0, 0, 0);
                }
                if (kc + 1 < 16) { T0_PARK((kc + 1) & 1); if (kc + 2 < 16) T0_ISSUE(kc + 2); }
                __syncthreads();
            }
#undef T0_PARK
#undef T0_ISSUE
#pragma unroll
            for (int i = 0; i < 16; ++i) p.PJ[(size_t)(unit2 * 32 + 32 * trw + 8 * (i >> 2) + 4 * hh + (i & 3)) * NPJ + NG1 + 32 * tcw + r] = f2bf(z[i]);
        }
        const int tid = otid(), wave = __builtin_amdgcn_readfirstlane(tid >> 6), lane = tid & 63, r = lane & 31, hh = lane >> 5;
        u16* sSCR = sRAW + wave * 4096;
        const int unit = unit2 + sub;
        const int t0 = unit * 32, b = t0 >> 12, s0 = t0 & (SEQ - 1);
#pragma unroll
        for (int e = tid; e < 32 * 128; e += 512) {
            const int tok = e >> 7, j = e & 127, col = C_WD + j;
            const size_t row = (size_t)(t0 + tok);
            const float cur = bf2f(p.PJ[row * NPJ + col]);
            const float prv = (s0 + tok > 0) ? bf2f(p.PJ[(row - 1) * NPJ + col]) : 0.f;
            const float v = cur + (prv - cur) * mu[col];
            if (j < 64) sXW[tok * ILD + j] = f2bf(1.f - 2.f * frcp(1.f + __expf(2.f * v)));
            else sXA[tok * ILD + (j - 64)] = f2bf(v);
        }
#pragma unroll
        for (int e = tid; e < 47 * 64; e += 512) {
            const int rr = e >> 6, seg = (e & 63) * 8, s = s0 - 15 + rr;
            uint4 v = make_uint4(0u, 0u, 0u, 0u);
            if (s >= 0) v = *(const uint4*)(p.PJ + (size_t)(t0 - 15 + rr) * NPJ + C_PU + seg);
            *(uint4*)(sRAW + rr * 512 + seg) = v;
        }
        __syncthreads();
        {
            const int c = tid, win = 2 << (c >> 7);
            float raw[47];
#pragma unroll
            for (int i = 0; i < 47; ++i) raw[i] = bf2f(sRAW[i * 512 + c]);
            float run = 0.f;
#pragma unroll
            for (int j = 1; j < 16; ++j) run += (j < win) ? raw[15 - j] : 0.f;
#pragma unroll
            for (int tok = 0; tok < 32; ++tok) {
                const int s = s0 + tok; const int n = (s + 1 < win) ? (s + 1) : win;
                const float uu = raw[15 + tok];
                run += uu;
                sD[tok * DLD + c] = f2bf(run * frcp((float)n) - uu);
                const float o2 = raw[15 + tok - 1], o4 = raw[15 + tok - 3], o8 = raw[15 + tok - 7], o16 = raw[15 + tok - 15];
                run -= (win == 2) ? o2 : (win == 4) ? o4 : (win == 8) ? o8 : o16;
            }
        }
        __syncthreads();
#pragma unroll 1
        for (int rnd = 0; rnd < 2; ++rnd) {
            const int hd = rnd ? 8 + (wave & 3) : wave;
            const int segb = rnd ? (wave >> 2) : 0, sege = rnd ? segb + 1 : 2;
            {
#pragma unroll 1
                for (int mat = 0; mat < 2; ++mat) {
                    const u16* X = mat ? sXA : sXW; const u16* WT = mat ? p.AUT : p.WUT;
                    f32x16 z0 = f16zero(), z1 = f16zero();
#pragma unroll
                    for (int s = 0; s < 4; ++s) {
                        const bf16x8 xf = *(const bf16x8*)(X + r * ILD + 16 * s + 8 * hh);
                        const bf16x8 w0f = *(const bf16x8*)(WT + (size_t)(hd * 64 + r) * 64 + 16 * s + 8 * hh), w1f = *(const bf16x8*)(WT + (size_t)(hd * 64 + 32 + r) * 64 + 16 * s + 8 * hh);
                        z0 = __builtin_amdgcn_mfma_f32_32x32x16_bf16(xf, w0f, z0, 0, 0, 0); z1 = __builtin_amdgcn_mfma_f32_32x32x16_bf16(xf, w1f, z1, 0, 0, 0);
                    }
#pragma unroll
                    for (int i = 0; i < 16; ++i) {
                        const int tok = 8 * (i >> 2) + 4 * hh + (i & 3);
                        sSCR[mat * 2048 + tok * 64 + r] = f2bf(z0[i]); sSCR[mat * 2048 + tok * 64 + 32 + r] = f2bf(z1[i]);
                    }
                }
                __builtin_amdgcn_fence(__ATOMIC_RELEASE, "workgroup"); __builtin_amdgcn_wave_barrier(); __builtin_amdgcn_fence(__ATOMIC_ACQUIRE, "workgroup");
            }
            const int c = hd * 64 + lane, n = lane, bh = b * NH + hd;
            const float w0c = w0[c], a0c = a0[c], kkc = k_k[c], kac = k_a[c], rkc = r_k[c], mur = mu[C_R + c], muk = mu[C_K + c];
            float lg = sub ? sLG[c] : 0.f;
            const u16* pk = p.PJ + (size_t)t0 * NPJ + C_K + c; const u16* pr = p.PJ + (size_t)t0 * NPJ + C_R + c;
            float kp = 0.f, rp = 0.f;
            if (segb == 0) { if (s0 > 0) { kp = bf2f(*(pk - NPJ)); rp = bf2f(*(pr - NPJ)); } }
            else {
                kp = bf2f(pk[(size_t)15 * NPJ]); rp = bf2f(pr[(size_t)15 * NPJ]);
#pragma unroll
                for (int t = 0; t < 16; ++t) lg -= 0.60653066f * frcp(1.f + __expf(-(w0c + bf2f(sSCR[t * 64 + n]))));
            }
            float gprev = __expf(lg);
#pragma unroll 1
            for (int seg = segb; seg < sege; ++seg) {
                const int tb = seg * 16;
                unsigned krraw[16];
#pragma unroll
                for (int i = 0; i < 16; ++i) krraw[i] = (unsigned)pk[(size_t)(tb + i) * NPJ] | ((unsigned)pr[(size_t)(tb + i) * NPJ] << 16);
#pragma unroll
                for (int i = 0; i < 16; ++i) {
                    const int t = tb + i, s = s0 + t;
                    const float lw = w0c + bf2f(sSCR[t * 64 + n]);
                    const float ee = 0.60653066f * frcp(1.f + __expf(-lw));
                    const float a = frcp(1.f + __expf(-(a0c + bf2f(sSCR[2048 + t * 64 + n]))));
                    const float kc = bflo(krraw[i]), rc = bfhi(krraw[i]);
                    const float ks = kc + (kp - kc) * muk, rs = rc + (rp - rc) * mur;
                    kp = kc; rp = rc;
                    const float kkv = ks * kkc;
                    const float ss = wave_sum_fast(kkv * kkv);
                    const float kk = kkv * rsqrtf(fmaxf(ss, 1e-24f));
                    const float kprime = ks * (1.f + (a - 1.f) * kac);
                    const float kka = kk * a;
                    const float bon = wave_sum_fast(rs * kprime * rkc);
                    const size_t rec = (size_t)bh * SEQ + s;
                    lg -= ee;
                    const float gcur = __expf(lg), ig = frcp(gcur);
                    p.KR[(rec * 4 + 0) * 64 + n] = f2bf(-gprev * kk); p.KR[(rec * 4 + 1) * 64 + n] = f2bf(kka * ig);
                    p.KR[(rec * 4 + 2) * 64 + n] = f2bf(kprime * ig); p.KR[(rec * 4 + 3) * 64 + n] = f2bf(rs * gcur);
                    if ((s & 63) == 63) p.GC[((size_t)bh * 64 + (s >> 6)) * 64 + n] = gcur;
                    if (n == 0) p.SBN[(size_t)(t0 + t) * NH + hd] = bon;
                    gprev = gcur;
                }
            }
            if (sege == 2) sLG[c] = lg;
        }
#define B1_LOAD(VV, BT) do { _Pragma("unroll") for (int i3 = 0; i3 < 3; ++i3) { const int it = (BT) * 3 + i3; \
            const int f = it * 512 + tid, fl = f & 63, dblk = (f >> 6) & 1, ks = (f >> 7) & 1, h = f >> 8, hh2 = fl >> 5, r2 = fl & 31; \
            _Pragma("unroll") for (int jp = 0; jp < 4; ++jp) { const int j0 = 2 * jp, j1 = 2 * jp + 1; \
                const int key0 = 16 * ks + 8 * (j0 >> 2) + 4 * hh2 + (j0 & 3), key1 = 16 * ks + 8 * (j1 >> 2) + 4 * hh2 + (j1 & 3); \
                const unsigned a0v = p.PJ[(size_t)(t0 + key0) * NPJ + C_AV + h * 64 + dblk * 32 + r2]; \
                const unsigned a1v = p.PJ[(size_t)(t0 + key1) * NPJ + C_AV + h * 64 + dblk * 32 + r2]; \
                VV[i3][jp] = a0v | (a1v << 16); } } } while (0)
#define B1_STORE(VV, BT) do { _Pragma("unroll") for (int i3 = 0; i3 < 3; ++i3) { const int it = (BT) * 3 + i3; \
            const int f = it * 512 + tid, fl = f & 63, dblk = (f >> 6) & 1, ks = (f >> 7) & 1, h = f >> 8; \
            uint4 o; o.x = VV[i3][0]; o.y = VV[i3][1]; o.z = VV[i3][2]; o.w = VV[i3][3]; \
            *(uint4*)(p.VF + ((((size_t)(b * NH + h) * 128 + (s0 >> 5)) * 2 + ks) * 2 + dblk) * 512 + fl * 8) = o; } } while (0)
#define B2_LOAD(UA, UB, BT) do { _Pragma("unroll") for (int i3 = 0; i3 < 3; ++i3) { const int it = (BT) * 3 + i3; \
            const int ridx = it * 128 + (tid >> 2), part = tid & 3; \
            const int which = ridx >= 384 ? 1 : 0, rr = ridx - which * 384, tok = rr / NH, h = rr - tok * NH; \
            const u16* ptr = p.PJ + (size_t)(t0 + tok) * NPJ + (which ? C_AK : C_AQ) + h * 64 + part * 16; \
            UA[i3] = *(const uint4*)ptr; UB[i3] = *(const uint4*)(ptr + 8); } } while (0)
        unsigned vvA[3][4], vvB[3][4]; uint4 uaA[3], ubA[3], uaB[3], ubB[3];
        {
            unsigned gate[2][8]; f32x16 zz[2]; float sc2[2];
#pragma unroll
            for (int ti = 0; ti < 2; ++ti) {
                const int tile = wave * 2 + ti, g = tile >> 2, ct = tile & 3, chn = g * 128 + 32 * ct + r;
                sc2[ti] = pool_scale[chn];
#pragma unroll
                for (int i = 0; i < 16; i += 2) gate[ti][i >> 1] = (unsigned)p.PJ[(size_t)(t0 + 8 * (i >> 2) + 4 * hh + (i & 3)) * NPJ + C_PG + chn] | ((unsigned)p.PJ[(size_t)(t0 + 8 * (i >> 2) + 4 * hh + (i & 3) + 1) * NPJ + C_PG + chn] << 16);
            }
            B1_LOAD(vvA, 0);
#pragma unroll
            for (int ti = 0; ti < 2; ++ti) {
                const int tile = wave * 2 + ti, g = tile >> 2, ct = tile & 3;
                f32x16 z = f16zero();
#pragma unroll
                for (int s = 0; s < 8; ++s) {
                    const bf16x8 a = *(const bf16x8*)(sD + r * DLD + g * 128 + 16 * s + 8 * hh);
                    const bf16x8 bq = *(const bf16x8*)(p.PWT + (size_t)(g * 128 + 32 * ct + r) * 128 + 16 * s + 8 * hh);
                    z = __builtin_amdgcn_mfma_f32_32x32x16_bf16(a, bq, z, 0, 0, 0);
                }
                zz[ti] = z;
            }
#pragma unroll
            for (int ti = 0; ti < 2; ++ti) {
                const int tile = wave * 2 + ti, g = tile >> 2, ct = tile & 3, chn = g * 128 + 32 * ct + r;
#pragma unroll
                for (int i = 0; i < 16; ++i) {
                    const size_t row = (size_t)(t0 + 8 * (i >> 2) + 4 * hh + (i & 3));
                    const float gt = (i & 1) ? bfhi(gate[ti][i >> 1]) : bflo(gate[ti][i >> 1]);
                    MIX[row * DM + 768 + chn] = f2bf(zz[ti][i] * sc2[ti] * silu(gt));
                }
            }
        }
        B1_STORE(vvA, 0);
        B1_LOAD(vvB, 1); B2_LOAD(uaA, ubA, 0);
        B1_STORE(vvB, 1);
        B2_LOAD(uaB, ubB, 1);
        {
#pragma unroll
            for (int i3 = 0; i3 < 3; ++i3) {
                const int it = 0 * 3 + i3;
                const int ridx = it * 128 + (tid >> 2), part = tid & 3;
                const int which = ridx >= 384 ? 1 : 0, rr = ridx - which * 384, tok = rr / NH, h = rr - tok * NH;
                u16* ptr = p.PJ + (size_t)(t0 + tok) * NPJ + (which ? C_AK : C_AQ) + h * 64 + part * 16;
                const uint4 u0 = uaA[i3], u1 = ubA[i3];
                float xv[16];
                xv[0] = bflo(u0.x); xv[1] = bfhi(u0.x); xv[2] = bflo(u0.y); xv[3] = bfhi(u0.y); xv[4] = bflo(u0.z); xv[5] = bfhi(u0.z); xv[6] = bflo(u0.w); xv[7] = bfhi(u0.w);
                xv[8] = bflo(u1.x); xv[9] = bfhi(u1.x); xv[10] = bflo(u1.y); xv[11] = bfhi(u1.y); xv[12] = bflo(u1.z); xv[13] = bfhi(u1.z); xv[14] = bflo(u1.w); xv[15] = bfhi(u1.w);
                float ss = 0.f;
#pragma unroll
                for (int i = 0; i < 16; ++i) ss += xv[i] * xv[i];
                ss += __shfl_xor(ss, 1); ss += __shfl_xor(ss, 2);
                const float inv = rsqrtf(ss * (1.f / 64.f) + 1e-6f) * (which ? 1.f : 0.125f * 1.44269504089f);
                const float* gg = (which ? kn_g : qn_g) + part * 16;
#pragma unroll
                for (int i = 0; i < 16; ++i) xv[i] = xv[i] * inv * gg[i];
                uint4 o0, o1;
                o0.x = pk2(xv[0], xv[1]); o0.y = pk2(xv[2], xv[3]); o0.z = pk2(xv[4], xv[5]); o0.w = pk2(xv[6], xv[7]);
                o1.x = pk2(xv[8], xv[9]); o1.y = pk2(xv[10], xv[11]); o1.z = pk2(xv[12], xv[13]); o1.w = pk2(xv[14], xv[15]);
                *(uint4*)ptr = o0; *(uint4*)(ptr + 8) = o1;
            }
        }
        {
#pragma unroll
            for (int i3 = 0; i3 < 3; ++i3) {
                const int it = 1 * 3 + i3;
                const int ridx = it * 128 + (tid >> 2), part = tid & 3;
                const int which = ridx >= 384 ? 1 : 0, rr = ridx - which * 384, tok = rr / NH, h = rr - tok * NH;
                u16* ptr = p.PJ + (size_t)(t0 + tok) * NPJ + (which ? C_AK : C_AQ) + h * 64 + part * 16;
                const uint4 u0 = uaB[i3], u1 = ubB[i3];
                float xv[16];
                xv[0] = bflo(u0.x); xv[1] = bfhi(u0.x); xv[2] = bflo(u0.y); xv[3] = bfhi(u0.y); xv[4] = bflo(u0.z); xv[5] = bfhi(u0.z); xv[6] = bflo(u0.w); xv[7] = bfhi(u0.w);
                xv[8] = bflo(u1.x); xv[9] = bfhi(u1.x); xv[10] = bflo(u1.y); xv[11] = bfhi(u1.y); xv[12] = bflo(u1.z); xv[13] = bfhi(u1.z); xv[14] = bflo(u1.w); xv[15] = bfhi(u1.w);
                float ss = 0.f;
#pragma unroll
                for (int i = 0; i < 16; ++i) ss += xv[i] * xv[i];
                ss += __shfl_xor(ss, 1); ss += __shfl_xor(ss, 2);
                const float inv = rsqrtf(ss * (1.f / 64.f) + 1e-6f) * (which ? 1.f : 0.125f * 1.44269504089f);
                const float* gg = (which ? kn_g : qn_g) + part * 16;
#pragma unroll
                for (int i = 0; i < 16; ++i) xv[i] = xv[i] * inv * gg[i];
                uint4 o0, o1;
                o0.x = pk2(xv[0], xv[1]); o0.y = pk2(xv[2], xv[3]); o0.z = pk2(xv[4], xv[5]); o0.w = pk2(xv[6], xv[7]);
                o1.x = pk2(xv[8], xv[9]); o1.y = pk2(xv[10], xv[11]); o1.z = pk2(xv[12], xv[13]); o1.w = pk2(xv[14], xv[15]);
                *(uint4*)ptr = o0; *(uint4*)(ptr + 8) = o1;
            }
        }
#undef B1_LOAD
#undef B1_STORE
#undef B2_LOAD
        __syncthreads();
    }
}

DI f32x16 mmnt(const u16* P, const u16* Q, int tr, int tc, int r, int hh, f32x16 acc) {
#pragma unroll
    for (int s = 0; s < 4; ++s) {
        const bf16x8 a = *(const bf16x8*)(P + (32 * tr + r) * ILD + 16 * s + 8 * hh);
        const bf16x8 b = *(const bf16x8*)(Q + (32 * tc + r) * ILD + 16 * s + 8 * hh);
        acc = __builtin_amdgcn_mfma_f32_32x32x16_bf16(a, b, acc, 0, 0, 0);
    }
    return acc;
}
DI void st_eff(u16* E, const f32x16& z, int tr, int tc, int r, int hh) {
#pragma unroll
    for (int g = 0; g < 4; ++g) { uint2 o; o.x = pk2(z[4 * g], z[4 * g + 1]); o.y = pk2(z[4 * g + 2], z[4 * g + 3]); *(uint2*)(E + (32 * tc + r) * ILD + 32 * tr + 8 * g + 4 * hh) = o; }
}
DI void st_scat(u16* F, const f32x16& z, int tr, int tc, int r, int hh) {
#pragma unroll
    for (int i = 0; i < 16; ++i) F[(32 * tr + 8 * (i >> 2) + 4 * hh + (i & 3)) * ILD + 32 * tc + r] = f2bf(z[i]);
}
#define SL(n) (img + (n) * IMG)
DI void rwkv_passA(const Params& p, int l, unsigned char* shm) {
    u16* img = (u16*)shm; float* gC = (float*)(shm + 16 * IMG * 2);
    const int tid = otid(), wave = __builtin_amdgcn_readfirstlane(tid >> 6), lane = tid & 63, r = lane & 31, hh = lane >> 5;
    const int grp = wave >> 2, tr = (wave >> 1) & 1, tc = wave & 1;
    const float* mu = p.mu_a + l * 3200;
    const int q = 32 * tc + r;
    uint4 sd0, sd1, sd2, sd3, scur, sprv, sga, sgp; float sgc = 0.f, ssb = 0.f;
    const float* gn_g = p.gn_g + l * 768; const float* gn_b = p.gn_b + l * 768;
    auto stage_load = [&](int cu2) __attribute__((always_inline)) {
        const int bh2 = cu2 >> 6, ch2 = cu2 & 63, b2 = bh2 / NH, h2 = bh2 - b2 * NH, t02 = ch2 * 64;
        const int a = tid >> 7, t = (tid >> 1) & 63, half = tid & 1;
        const u16* src = p.KR + (((size_t)bh2 * SEQ + t02 + t) * 4 + a) * 64 + half * 32;
        sd0 = *(const uint4*)(src); sd1 = *(const uint4*)(src + 8); sd2 = *(const uint4*)(src + 16); sd3 = *(const uint4*)(src + 24);
        const int tv = tid >> 3, vs = (tid & 7) * 8;
        const u16* pv = p.PJ + ((size_t)b2 * SEQ + t02 + tv) * NPJ + C_V + h2 * 64 + vs;
        scur = *(const uint4*)pv;
        sprv = make_uint4(0u, 0u, 0u, 0u); sgp = make_uint4(0u, 0u, 0u, 0u);
        sga = *(const uint4*)(pv + (C_G - C_V));
        if (t02 + tv > 0) { sprv = *(const uint4*)(pv - NPJ); sgp = *(const uint4*)(pv - NPJ + (C_G - C_V)); }
        ssb = p.SBN[((size_t)b2 * SEQ + t02 + tv) * NH + h2];
        if (tid < 64) sgc = p.GC[(size_t)cu2 * 64 + tid];
    };
    if (obid() < 48 * 64) stage_load(obid());
#pragma unroll 1
    for (int cu = obid(); cu < 48 * 64; cu += gridDim.x) {
        const int bh = cu >> 6, ch = cu & 63, b = bh / NH, h = bh - b * NH, t0 = ch * 64;
        {
            const int a = tid >> 7, t = (tid >> 1) & 63, half = tid & 1;
            const uint4 d[4] = {sd0, sd1, sd2, sd3};
            u16* dst = SL(a) + t * ILD + half * 32;
#pragma unroll
            for (int j = 0; j < 4; ++j) *(uint4*)(dst + 8 * j) = d[j];
            if (a < 3) {
                u16* dT = SL(4 + a) + (half * 32) * ILD + t;
#pragma unroll
                for (int j = 0; j < 4; ++j) {
                    const unsigned w4[4] = {d[j].x, d[j].y, d[j].z, d[j].w};
#pragma unroll
                    for (int e = 0; e < 4; ++e) { dT[(8 * j + 2 * e) * ILD] = (u16)(w4[e] & 0xffffu); dT[(8 * j + 2 * e + 1) * ILD] = (u16)(w4[e] >> 16); }
                }
            }
            const int tv = tid >> 3, vs = (tid & 7) * 8;
            const unsigned cw[4] = {scur.x, scur.y, scur.z, scur.w}, pw[4] = {sprv.x, sprv.y, sprv.z, sprv.w};
            u16* vT = SL(7) + vs * ILD + tv;
            const unsigned gw[4] = {sga.x, sga.y, sga.z, sga.w}, gq[4] = {sgp.x, sgp.y, sgp.z, sgp.w};
            unsigned a1o[4], a2o[4];
#pragma unroll
            for (int e = 0; e < 4; ++e) {
                const int ch0 = h * 64 + vs + 2 * e;
                const float c0 = bflo(cw[e]), c1 = bfhi(cw[e]), p0 = bflo(pw[e]), p1 = bfhi(pw[e]);
                const float v0 = c0 + (p0 - c0) * mu[C_V + ch0], v1 = c1 + (p1 - c1) * mu[C_V + ch0 + 1];
                vT[(2 * e) * ILD] = f2bf(v0);
                vT[(2 * e + 1) * ILD] = f2bf(v1);
                const float g0 = bflo(gw[e]), g1 = bfhi(gw[e]), q0 = bflo(gq[e]), q1 = bfhi(gq[e]);
                const float sl0 = silu(g0 + (q0 - g0) * mu[C_G + ch0]), sl1 = silu(g1 + (q1 - g1) * mu[C_G + ch0 + 1]);
                a1o[e] = pk2(gn_g[ch0] * sl0, gn_g[ch0 + 1] * sl1);
                a2o[e] = pk2((gn_b[ch0] + ssb * v0) * sl0, (gn_b[ch0 + 1] + ssb * v1) * sl1);
            }
            *(uint4*)(p.HB + ((size_t)b * SEQ + t0 + tv) * DM + h * 64 + vs) = make_uint4(a1o[0], a1o[1], a1o[2], a1o[3]);
            *(uint4*)(p.PJ + ((size_t)b * SEQ + t0 + tv) * NPJ + C_K + h * 64 + vs) = make_uint4(a2o[0], a2o[1], a2o[2], a2o[3]);
            if (tid < 64) gC[tid] = sgc;
        }
        if (cu + (int)gridDim.x < 48 * 64) stage_load(cu + gridDim.x);
        __syncthreads();
        if (grp == 0) {
            f32x16 z = mmnt(SL(0), SL(1), tr, tc, r, hh, f16zero());
            f32x16 tt;
#pragma unroll
            for (int i = 0; i < 16; ++i) { const int pp = 32 * tr + 8 * (i >> 2) + 4 * hh + (i & 3); z[i] = (q < pp) ? z[i] : 0.f; tt[i] = z[i] + ((q == pp) ? 1.f : 0.f); }
            st_eff(SL(9), z, tr, tc, r, hh); st_scat(SL(8), z, tr, tc, r, hh); st_eff(SL(12), tt, tr, tc, r, hh);
        } else {
            f32x16 z = mmnt(SL(2), SL(0), tr, tc, r, hh, f16zero());
#pragma unroll
            for (int i = 0; i < 16; ++i) { const int pp = 32 * tr + 8 * (i >> 2) + 4 * hh + (i & 3); z[i] = (pp < q) ? z[i] : 0.f; }
            st_eff(SL(14), z, tr, tc, r, hh);
        }
        __syncthreads();
        if (grp == 0) { const f32x16 z = mmnt(SL(8), SL(9), tr, tc, r, hh, f16zero()); st_eff(SL(11), z, tr, tc, r, hh); st_scat(SL(10), z, tr, tc, r, hh); }
        else { const f32x16 z = mmnt(SL(14), SL(7), tr, tc, r, hh, f16zero()); st_eff(SL(15), z, tr, tc, r, hh); }
        __syncthreads();
#pragma unroll 1
        for (int m = 0; m < 4; ++m) {
            const int even = (m & 1) == 0;
            u16* Lr = even ? SL(10) : SL(8); u16* Ltr = even ? SL(11) : SL(9); u16* Lw = even ? SL(8) : SL(10); u16* Ltw = even ? SL(9) : SL(11);
            u16* TTr = even ? SL(12) : SL(13); u16* TTw = even ? SL(13) : SL(12);
            if (grp == 0) { const f32x16 z = mmnt(Lr, Ltr, tr, tc, r, hh, f16zero()); st_eff(Ltw, z, tr, tc, r, hh); st_scat(Lw, z, tr, tc, r, hh); }
            else {
                f32x16 z = mmnt(Lr, TTr, tr, tc, r, hh, f16zero());
#pragma unroll
                for (int g = 0; g < 4; ++g) { const uint2 o = *(const uint2*)(TTr + q * ILD + 32 * tr + 8 * g + 4 * hh); z[4 * g] += bflo(o.x); z[4 * g + 1] += bfhi(o.x); z[4 * g + 2] += bflo(o.y); z[4 * g + 3] += bfhi(o.y); }
                st_eff(TTw, z, tr, tc, r, hh);
            }
            __syncthreads();
        }
        if (grp == 1) {
            f32x16 z = mmnt(SL(10), SL(12), tr, tc, r, hh, f16zero());
#pragma unroll
            for (int g = 0; g < 4; ++g) { const uint2 o = *(const uint2*)(SL(12) + q * ILD + 32 * tr + 8 * g + 4 * hh); z[4 * g] += bflo(o.x); z[4 * g + 1] += bfhi(o.x); z[4 * g + 2] += bflo(o.y); z[4 * g + 3] += bfhi(o.y); }
            st_scat(SL(0), z, tr, tc, r, hh);
        } else {
            f32x16 z = mmnt(SL(1), SL(3), tr, tc, r, hh, f16zero());
#pragma unroll
            for (int i = 0; i < 16; ++i) { const int pp = 32 * tr + 8 * (i >> 2) + 4 * hh + (i & 3); z[i] = (pp <= q) ? z[i] : 0.f; }
            st_eff(SL(14), z, tr, tc, r, hh);
            z = mmnt(SL(2), SL(3), tr, tc, r, hh, f16zero());
#pragma unroll
            for (int i = 0; i < 16; ++i) { const int pp = 32 * tr + 8 * (i >> 2) + 4 * hh + (i & 3); z[i] = (pp <= q) ? z[i] : 0.f; }
            st_eff(SL(8), z, tr, tc, r, hh);
        }
        __syncthreads();
        if (grp == 0) { const f32x16 z = mmnt(SL(0), SL(15), tr, tc, r, hh, f16zero()); st_eff(SL(9), z, tr, tc, r, hh); }
        else { const f32x16 z = mmnt(SL(0), SL(4), tr, tc, r, hh, f16zero()); st_eff(SL(10), z, tr, tc, r, hh); }
        __syncthreads();
        const size_t tokq = (size_t)bh * SEQ + t0 + q;
        if (grp == 0) {
            f32x16 z = mmnt(SL(10), SL(5), tr, tc, r, hh, f16zero());
            const float gq = gC[q];
            u16* gt = p.GH + (size_t)cu * 8192 + q * 64 + 32 * tr + 4 * hh;
#pragma unroll
            for (int g = 0; g < 4; ++g) { uint2 o; o.x = pk2(z[4 * g] * gq, z[4 * g + 1] * gq); o.y = pk2(z[4 * g + 2] * gq, z[4 * g + 3] * gq); *(uint2*)(gt + 8 * g) = o; }
            z = mmnt(SL(10), SL(14), tr, tc, r, hh, f16zero());
            u16* rp = p.KR + (tokq * 4 + 3) * 64 + 32 * tr + 4 * hh;
#pragma unroll
            for (int g = 0; g < 4; ++g) {
                const uint2 o = *(const uint2*)(SL(3) + q * ILD + 32 * tr + 8 * g + 4 * hh);
                uint2 w; w.x = pk2(z[4 * g] + bflo(o.x), z[4 * g + 1] + bfhi(o.x)); w.y = pk2(z[4 * g + 2] + bflo(o.y), z[4 * g + 3] + bfhi(o.y));
                *(uint2*)(rp + 8 * g) = w;
            }
        } else {
            f32x16 z = mmnt(SL(5), SL(9), tr, tc, r, hh, f16zero());
            z = mmnt(SL(6), SL(7), tr, tc, r, hh, z);
            u16* hp = p.GH + (size_t)cu * 8192 + 4096 + q * 64 + 32 * tr + 4 * hh;
#pragma unroll
            for (int g = 0; g < 4; ++g) {
                const float4 gg = *(const float4*)(gC + 32 * tr + 8 * g + 4 * hh);
                uint2 o; o.x = pk2(z[4 * g] * gg.x, z[4 * g + 1] * gg.y); o.y = pk2(z[4 * g + 2] * gg.z, z[4 * g + 3] * gg.w);
                *(uint2*)(hp + 8 * g) = o;
            }
            z = mmnt(SL(9), SL(14), tr, tc, r, hh, f16zero());
            z = mmnt(SL(7), SL(8), tr, tc, r, hh, z);
            u16* yp = p.PJ + ((size_t)b * SEQ + t0 + q) * NPJ + C_PU + h * 64 + 32 * tr + 4 * hh;
#pragma unroll
            for (int g = 0; g < 4; ++g) { uint2 o; o.x = pk2(z[4 * g], z[4 * g + 1]); o.y = pk2(z[4 * g + 2], z[4 * g + 3]); *(uint2*)(yp + 8 * g) = o; }
        }
        __syncthreads();
    }
}

DI void rwkv_passB(const Params& p, unsigned char* shm) {
    u16* img = (u16*)shm;
    constexpr int RS = 4 * IMG + 128;
    u16* ring = img + 4 * IMG;
    const int tid = otid(), wave = __builtin_amdgcn_readfirstlane(tid >> 6), lane = tid & 63, r = lane & 31, hh = lane >> 5;
    const int bh = obid(), b = bh / NH, h = bh - b * NH;
    if (wave >= 4) {
        const int lt = tid - 256;
        auto ld = [&](int jj, int chn) __attribute__((always_inline)) -> uint4 {
            const size_t cu = (size_t)bh * 64 + chn; const int t0 = chn * 64;
            const int idx = lt + 256 * (jj & 1), row = idx >> 3, c8 = idx & 7; const u16* src;
            if ((jj >> 1) == 0) src = p.GH + cu * 8192 + row * 64 + c8 * 8;
            else if ((jj >> 1) == 1) src = p.KR + (((size_t)bh * SEQ + t0 + row) * 4 + 3) * 64 + c8 * 8;
            else if ((jj >> 1) == 2) src = p.GH + cu * 8192 + 4096 + row * 64 + c8 * 8;
            else if ((jj >> 1) == 3) src = p.PJ + ((size_t)b * SEQ + t0 + row) * NPJ + C_PU + h * 64 + c8 * 8;
            else if ((jj >> 1) == 4) src = p.HB + ((size_t)b * SEQ + t0 + row) * DM + h * 64 + c8 * 8;
            else src = p.PJ + ((size_t)b * SEQ + t0 + row) * NPJ + C_K + h * 64 + c8 * 8;
            return *(const uint4*)src;
        };
        auto stp = [&](int jj, int slot, const uint4& v) __attribute__((always_inline)) {
            const int idx = lt + 256 * (jj & 1), row = idx >> 3, c8 = idx & 7;
            *(uint4*)(ring + slot * RS + (jj >> 1) * IMG + row * ILD + c8 * 8) = v;
        };
        auto ldg = [&](int chn) __attribute__((always_inline)) -> float4 { float4 g = make_float4(0.f, 0.f, 0.f, 0.f); if (lt < 16) g = *(const float4*)(p.GC + ((size_t)bh * 64 + chn) * 64 + lt * 4); return g; };
        auto stg = [&](int slot, const float4& g) __attribute__((always_inline)) { if (lt < 16) *(float4*)((float*)(ring + slot * RS + 4 * IMG) + lt * 4) = g; };
        auto emit = [&](int chn, int j2, const uint4& a1, const uint4& a2) __attribute__((always_inline)) {
            const int idx = lt + 256 * j2, row = idx >> 3, c8 = idx & 7;
            const uint4 nv = *(const uint4*)(img + (2 + (chn & 1)) * IMG + row * ILD + c8 * 8);
            const unsigned nn[4] = {nv.x, nv.y, nv.z, nv.w}, x1[4] = {a1.x, a1.y, a1.z, a1.w}, x2[4] = {a2.x, a2.y, a2.z, a2.w};
            unsigned o[4];
#pragma unroll
            for (int e = 0; e < 4; ++e) o[e] = pk2(bflo(nn[e]) * bflo(x1[e]) + bflo(x2[e]), bfhi(nn[e]) * bfhi(x1[e]) + bfhi(x2[e]));
            *(uint4*)(p.HB + ((size_t)b * SEQ + chn * 64 + row) * DM + h * 64 + c8 * 8) = make_uint4(o[0], o[1], o[2], o[3]);
        };
#define PB_DECL(S) uint4 a##S##0, a##S##1, a##S##2, a##S##3, a##S##4, a##S##5, a##S##6, a##S##7; float4 g##S
#define PB_ISSUE(S, CH) do { a##S##0 = ld(0, CH); a##S##1 = ld(1, CH); a##S##2 = ld(2, CH); a##S##3 = ld(3, CH); a##S##4 = ld(4, CH); a##S##5 = ld(5, CH); a##S##6 = ld(6, CH); a##S##7 = ld(7, CH); g##S = ldg(CH); } while (0)
#define PB_WRITE(S, SLOT) do { stp(0, SLOT, a##S##0); stp(1, SLOT, a##S##1); stp(2, SLOT, a##S##2); stp(3, SLOT, a##S##3); stp(4, SLOT, a##S##4); stp(5, SLOT, a##S##5); stp(6, SLOT, a##S##6); stp(7, SLOT, a##S##7); stg(SLOT, g##S); } while (0)
#define PA_DECL(S) uint4 f##S##0, f##S##1, f##S##2, f##S##3
#define PA_ISSUE(S, CH) do { f##S##0 = ld(8, CH); f##S##1 = ld(9, CH); f##S##2 = ld(10, CH); f##S##3 = ld(11, CH); } while (0)
#define PA_EMIT(S, CH) do { emit(CH, 0, f##S##0, f##S##2); emit(CH, 1, f##S##1, f##S##3); } while (0)
        PB_DECL(0); PB_DECL(1);
        PA_DECL(0); PA_DECL(1); PA_DECL(2); PA_DECL(3); PA_DECL(4); PA_DECL(5);
        PB_ISSUE(0, 0); PB_ISSUE(1, 1);
        PA_ISSUE(0, 0); PA_ISSUE(1, 1); PA_ISSUE(2, 2); PA_ISSUE(3, 3);
        PB_WRITE(0, 0); PB_ISSUE(0, 2);
        PB_WRITE(1, 1); PB_ISSUE(1, 3);
        __syncthreads();
#define PB_STEP(U, RSET, SLOT, AEM, AIS) do { const int st = c6 + (U); if (st < 64) { \
            if (st >= 1) PA_EMIT(AEM, st - 1); \
            if (st + 2 < 64) { PB_WRITE(RSET, SLOT); if (st + 4 < 64) PB_ISSUE(RSET, st + 4); } \
            if (st + 4 < 64) PA_ISSUE(AIS, st + 4); \
            __syncthreads(); } } while (0)
#pragma unroll 1
        for (int c6 = 0; c6 < 66; c6 += 6) {
            PB_STEP(0, 0, 2, 5, 4); PB_STEP(1, 1, 0, 0, 5); PB_STEP(2, 0, 1, 1, 0); PB_STEP(3, 1, 2, 2, 1); PB_STEP(4, 0, 0, 3, 2); PB_STEP(5, 1, 1, 4, 3);
        }
        PA_EMIT(3, 63);
#undef PB_STEP
#undef PB_DECL
#undef PB_ISSUE
#undef PB_WRITE
#undef PA_DECL
#undef PA_ISSUE
#undef PA_EMIT
        return;
    }
    if (wave >= 2) {
        const int tr = wave - 2;
        f32x16 S0 = f16zero(), S1 = f16zero();
        st_eff(SL(0), S0, tr, 0, r, hh); st_eff(SL(0), S1, tr, 1, r, hh);
        __syncthreads();
#pragma unroll 1
        for (int ch = 0; ch < 64; ++ch) {
            const u16* Si = SL(ch & 1);
            const u16* rs = ring + (ch % 3) * RS;
            const u16 *GTi = rs, *Hi = rs + 2 * IMG; const float* gCi = (const float*)(rs + 4 * IMG);
            f32x16 z0 = f16zero(), z1 = f16zero();
#pragma unroll
            for (int s = 0; s < 4; ++s) {
                const bf16x8 ga = *(const bf16x8*)(GTi + (32 * tr + r) * ILD + 16 * s + 8 * hh);
                const bf16x8 sb0 = *(const bf16x8*)(Si + r * ILD + 16 * s + 8 * hh), sb1 = *(const bf16x8*)(Si + (32 + r) * ILD + 16 * s + 8 * hh);
                z0 = __builtin_amdgcn_mfma_f32_32x32x16_bf16(ga, sb0, z0, 0, 0, 0);
                z1 = __builtin_amdgcn_mfma_f32_32x32x16_bf16(ga, sb1, z1, 0, 0, 0);
            }
#pragma unroll
            for (int g = 0; g < 4; ++g) {
                const float4 gg = *(const float4*)(gCi + 32 * tr + 8 * g + 4 * hh);
                const uint2 h0 = *(const uint2*)(Hi + r * ILD + 32 * tr + 8 * g + 4 * hh), h1 = *(const uint2*)(Hi + (32 + r) * ILD + 32 * tr + 8 * g + 4 * hh);
                S0[4 * g] = S0[4 * g] * gg.x + z0[4 * g] + bflo(h0.x); S0[4 * g + 1] = S0[4 * g + 1] * gg.y + z0[4 * g + 1] + bfhi(h0.x);
                S0[4 * g + 2] = S0[4 * g + 2] * gg.z + z0[4 * g + 2] + bflo(h0.y); S0[4 * g + 3] = S0[4 * g + 3] * gg.w + z0[4 * g + 3] + bfhi(h0.y);
                S1[4 * g] = S1[4 * g] * gg.x + z1[4 * g] + bflo(h1.x); S1[4 * g + 1] = S1[4 * g + 1] * gg.y + z1[4 * g + 1] + bfhi(h1.x);
                S1[4 * g + 2] = S1[4 * g + 2] * gg.z + z1[4 * g + 2] + bflo(h1.y); S1[4 * g + 3] = S1[4 * g + 3] * gg.w + z1[4 * g + 3] + bfhi(h1.y);
            }
            st_eff(SL((ch + 1) & 1), S0, tr, 0, r, hh); st_eff(SL((ch + 1) & 1), S1, tr, 1, r, hh);
            __syncthreads();
        }
        return;
    }
    {
        const int tc = wave, q = 32 * tc + r;
        __syncthreads();
#pragma unroll 1
        for (int ch = 0; ch < 64; ++ch) {
            const u16* Si = SL(ch & 1);
            const u16* rs = ring + (ch % 3) * RS;
            const u16 *RPi = rs + IMG, *YVi = rs + 3 * IMG;
            u16* Ni = img + (2 + (ch & 1)) * IMG;
            f32x16 z0 = f16zero(), z1 = f16zero();
#pragma unroll
            for (int s = 0; s < 4; ++s) {
                const bf16x8 rb = *(const bf16x8*)(RPi + q * ILD + 16 * s + 8 * hh);
                const bf16x8 sa0 = *(const bf16x8*)(Si + r * ILD + 16 * s + 8 * hh), sa1 = *(const bf16x8*)(Si + (32 + r) * ILD + 16 * s + 8 * hh);
                z0 = __builtin_amdgcn_mfma_f32_32x32x16_bf16(sa0, rb, z0, 0, 0, 0);
                z1 = __builtin_amdgcn_mfma_f32_32x32x16_bf16(sa1, rb, z1, 0, 0, 0);
            }
            float s1 = 0.f, s2 = 0.f;
#pragma unroll
            for (int g = 0; g < 4; ++g) {
                const uint2 y0 = *(const uint2*)(YVi + q * ILD + 8 * g + 4 * hh), y1 = *(const uint2*)(YVi + q * ILD + 32 + 8 * g + 4 * hh);
                z0[4 * g] += bflo(y0.x); z0[4 * g + 1] += bfhi(y0.x); z0[4 * g + 2] += bflo(y0.y); z0[4 * g + 3] += bfhi(y0.y);
                z1[4 * g] += bflo(y1.x); z1[4 * g + 1] += bfhi(y1.x); z1[4 * g + 2] += bflo(y1.y); z1[4 * g + 3] += bfhi(y1.y);
#pragma unroll
                for (int e = 0; e < 4; ++e) { s1 += z0[4 * g + e] + z1[4 * g + e]; s2 += z0[4 * g + e] * z0[4 * g + e] + z1[4 * g + e] * z1[4 * g + e]; }
            }
            s1 += __shfl_xor(s1, 32); s2 += __shfl_xor(s2, 32);
            const float mean = s1 * (1.f / 64.f);
            const float rstd = rsqrtf(fmaxf(s2 * (1.f / 64.f) - mean * mean, 0.f) + 64e-5f);
#pragma unroll
            for (int g = 0; g < 4; ++g) {
                uint2 o0, o1;
                o0.x = pk2((z0[4 * g] - mean) * rstd, (z0[4 * g + 1] - mean) * rstd); o0.y = pk2((z0[4 * g + 2] - mean) * rstd, (z0[4 * g + 3] - mean) * rstd);
                o1.x = pk2((z1[4 * g] - mean) * rstd, (z1[4 * g + 1] - mean) * rstd); o1.y = pk2((z1[4 * g + 2] - mean) * rstd, (z1[4 * g + 3] - mean) * rstd);
                *(uint2*)(Ni + q * ILD + 8 * g + 4 * hh) = o0; *(uint2*)(Ni + q * ILD + 32 + 8 * g + 4 * hh) = o1;
            }
            __syncthreads();
        }
    }
}
#undef SL

DI void attn_unit(const Params& p, int unit) {
    const int lane = otid() & 63, r = lane & 31, hh = lane >> 5;
    const int bh = unit >> 7, qt = unit & 127, b = bh / NH, h = bh - b * NH;
    const int q0 = qt * 32, qrow = q0 + r;
    const u16* pjb = p.PJ + (size_t)b * SEQ * NPJ;
    bf16x8 qf[4];
#pragma unroll
    for (int ks = 0; ks < 4; ++ks) qf[ks] = *(const bf16x8*)(pjb + (size_t)(q0 + r) * NPJ + C_AQ + h * 64 + ks * 16 + hh * 8);
    f32x16 O0, O1;
#pragma unroll
    for (int i = 0; i < 16; ++i) { O0[i] = 0.f; O1[i] = 0.f; }
    float carry = 0.f;
    bf16x8 kf[4], v00, v01, v10, v11;
#define AT_LOAD(KF, V00, V01, V10, V11, KT) do { const int _k0 = (KT) * 32; \
        _Pragma("unroll") for (int ks = 0; ks < 4; ++ks) KF[ks] = *(const bf16x8*)(pjb + (size_t)(_k0 + r) * NPJ + C_AK + h * 64 + ks * 16 + hh * 8); \
        const u16* _vfp = p.VF + (((size_t)bh * 128 + (KT)) * 4) * 512 + lane * 8; \
        V00 = *(const bf16x8*)(_vfp); V01 = *(const bf16x8*)(_vfp + 512); V10 = *(const bf16x8*)(_vfp + 1024); V11 = *(const bf16x8*)(_vfp + 1536); } while (0)
    AT_LOAD(kf, v00, v01, v10, v11, qt);
    bf16x8 kf2[4], w00, w01, w10, w11;
    if (qt > 0) AT_LOAD(kf2, w00, w01, w10, w11, qt - 1);
    const u16* gp = p.PJ + ((size_t)b * SEQ + q0 + r) * NPJ + C_AG + h * 64;
    uint2 gu[8];
#pragma unroll
    for (int i = 0; i < 8; ++i) gu[i] = *(const uint2*)(gp + (i >> 2) * 32 + 8 * (i & 3) + 4 * hh);
#pragma unroll 1
    for (int kt = qt; kt >= 0; --kt) {
        const int k0 = kt * 32;
        bf16x8 kf3[4], x00, x01, x10, x11;
        if (kt > 1) AT_LOAD(kf3, x00, x01, x10, x11, kt - 2);
        f32x16 z;
#pragma unroll
        for (int i = 0; i < 16; ++i) z[i] = 0.f;
#pragma unroll
        for (int ks = 0; ks < 4; ++ks) z = __builtin_amdgcn_mfma_f32_32x32x16_bf16(kf[ks], qf[ks], z, 0, 0, 0);
        float l1m[16], lb[16];
#pragma unroll
        for (int i = 0; i < 16; ++i) {
            const int key = k0 + (i & 3) + 8 * (i >> 2) + 4 * hh;
            const float zz = z[i];
            const float sp = fmaxf(zz, 0.f) + __builtin_amdgcn_logf(1.f + __builtin_amdgcn_exp2f(-fabsf(zz)));
            l1m[i] = (key < qrow) ? -sp : 0.f;
            lb[i] = (key < qrow) ? (zz - sp) : -1e30f;
        }
        float Gs[4], Gp[4];
#pragma unroll
        for (int g = 0; g < 4; ++g) { Gs[g] = (l1m[4 * g] + l1m[4 * g + 1]) + (l1m[4 * g + 2] + l1m[4 * g + 3]); Gp[g] = __shfl_xor(Gs[g], 32); }
        float E[4];
        const float keep = hh ? 0.f : 1.f;
        E[3] = keep * Gp[3];
        E[2] = Gs[3] + Gp[3] + keep * Gp[2];
        E[1] = Gs[3] + Gs[2] + Gp[3] + Gp[2] + keep * Gp[1];
        E[0] = Gs[3] + Gs[2] + Gs[1] + Gp[3] + Gp[2] + Gp[1] + keep * Gp[0];
        float w[16];
#pragma unroll
        for (int g = 0; g < 4; ++g) {
            float a = carry + E[g];
            w[4 * g + 3] = __builtin_amdgcn_exp2f(lb[4 * g + 3] + a); a += l1m[4 * g + 3];
            w[4 * g + 2] = __builtin_amdgcn_exp2f(lb[4 * g + 2] + a); a += l1m[4 * g + 2];
            w[4 * g + 1] = __builtin_amdgcn_exp2f(lb[4 * g + 1] + a); a += l1m[4 * g + 1];
            w[4 * g + 0] = __builtin_amdgcn_exp2f(lb[4 * g + 0] + a);
        }
        carry += (Gs[0] + Gs[1]) + (Gs[2] + Gs[3]) + (Gp[0] + Gp[1]) + (Gp[2] + Gp[3]);
        union { unsigned u[4]; bf16x8 v; } x0, x1;
#pragma unroll
        for (int j = 0; j < 4; ++j) { x0.u[j] = pk2(w[2 * j], w[2 * j + 1]); x1.u[j] = pk2(w[8 + 2 * j], w[8 + 2 * j + 1]); }
        O0 = __builtin_amdgcn_mfma_f32_32x32x16_bf16(v00, x0.v, O0, 0, 0, 0);
        O1 = __builtin_amdgcn_mfma_f32_32x32x16_bf16(v01, x0.v, O1, 0, 0, 0);
        O0 = __builtin_amdgcn_mfma_f32_32x32x16_bf16(v10, x1.v, O0, 0, 0, 0);
        O1 = __builtin_amdgcn_mfma_f32_32x32x16_bf16(v11, x1.v, O1, 0, 0, 0);
        if (__all(carry < -150.f)) break;
        if (kt > 0) {
#pragma unroll
            for (int ks = 0; ks < 4; ++ks) { kf[ks] = kf2[ks]; kf2[ks] = kf3[ks]; }
            v00 = w00; v01 = w01; v10 = w10; v11 = w11;
            w00 = x00; w01 = x01; w10 = x10; w11 = x11;
        }
    }
#undef AT_LOAD
    const size_t row = (size_t)b * SEQ + q0 + r;
    u16* mp = p.HB + row * DM + 1280 + h * 64;
#pragma unroll
    for (int dblk = 0; dblk < 2; ++dblk)
#pragma unroll
        for (int g = 0; g < 4; ++g) {
            const int d = dblk * 32 + 8 * g + 4 * hh;
            const uint2 gv = gu[dblk * 4 + g];
            const float o0 = dblk ? O1[4 * g + 0] : O0[4 * g + 0], o1 = dblk ? O1[4 * g + 1] : O0[4 * g + 1], o2 = dblk ? O1[4 * g + 2] : O0[4 * g + 2], o3 = dblk ? O1[4 * g + 3] : O0[4 * g + 3];
            uint2 o; o.x = pk2(o0 * silu(bflo(gv.x)), o1 * silu(bfhi(gv.x))); o.y = pk2(o2 * silu(bflo(gv.y)), o3 * silu(bfhi(gv.y)));
            *(uint2*)(mp + d) = o;
        }
}

DI void phase_p4b(const Params& p, int l, unsigned char* shm) {
    constexpr int NB = 48, UA = 6144;
    const int wave = __builtin_amdgcn_readfirstlane(otid() >> 6);
    if (obid() < NB) {
        rwkv_passB(p, shm);
        for (int u = UA + obid() * 8 + wave; u < 48 * 128; u += NB * 8) attn_unit(p, u);
        return;
    }
    for (int u = (obid() - NB) * 8 + wave; u < UA; u += (gridDim.x - NB) * 8) attn_unit(p, u);
    if (l == 0) { __syncthreads(); convert_weights(p, 1, shm, obid() - NB, gridDim.x - NB, 0, 32 * (NPJ / 256)); }
}

DI void run_phase(const Params& p, int ph, int l, unsigned char* shm) {
    switch (ph) {
    case 0: phase_p1(p, l, shm); break;
    case 1: { pg8::Gemm g{p.HB, p.W1, MTOK, NG1, DM}; pg8::StaticOrder S; S.init(MTOK, NG1, gridDim.x, obid()); pg8::EpiBf16 E{p.PJ, NPJ};
              pg8::gemm_phase<pg8::EpiBf16, pg8::StaticOrder>((PG8_LAS unsigned char*)shm, g, S, E); } break;
    case 2: phase_p3(p, l, shm); break;
    case 3: rwkv_passA(p, l, shm); break;
    case 4: phase_p4b(p, l, shm); break;
    case 6: { pg8::Gemm g{p.HB, p.W2, MTOK, DM, DM}; pg8::StaticOrder S; S.init(MTOK, DM, gridDim.x, obid()); pg8::EpiRes E{l == 0 ? p.x : p.out, p.out, DM, l == 1 ? 1 : 0};
              pg8::gemm_phase<pg8::EpiRes, pg8::StaticOrder>((PG8_LAS unsigned char*)shm, g, S, E); } break;
    }
}

#if MK_COOP
__global__ __launch_bounds__(512, 2) void mk_fwd(Params p, int ph_lo, int ph_hi) {
    extern __shared__ __attribute__((aligned(16))) unsigned char shm[];
    volatile LAS unsigned* st = (volatile LAS unsigned*)((LAS unsigned char*)shm + 148 * 1024);
    if (threadIdx.x < 2) st[threadIdx.x] = 0u;
    __syncthreads();
    const XcdBarrier xb = xcd_barrier_post(p.BAR, st);
    if (p.x == nullptr) cg::this_grid().sync();
#pragma unroll 1
    for (int l = 0; l < 2; ++l) {
        run_phase(p, 0, l, shm); xcd_barrier(xb);
        run_phase(p, 1, l, shm); xcd_barrier(xb);
        run_phase(p, 2, l, shm); xcd_barrier(xb);
        run_phase(p, 3, l, shm); xcd_barrier(xb);
        run_phase(p, 4, l, shm); xcd_barrier(xb);
        run_phase(p, 6, l, shm); if (l == 0) xcd_barrier(xb);
    }
}
#define MK_KERNEL mk_fwd
#else
template <int PH> __global__ __launch_bounds__(512, 2) void k_ph(Params p, int l) {
    extern __shared__ __attribute__((aligned(16))) unsigned char shm[];
    run_phase(p, PH, l, shm);
}
#define MK_KERNEL k_ph<1>
#endif

extern "C" void kernel_launch(void* const* d_in, const int* in_sizes, int n_in, void* d_out, int out_size, void* d_ws, size_t ws_size, hipStream_t stream) {
    static int grid = 0;
    if (grid == 0) {
        int dev = 0, cus = 0, per_cu = 0;
        (void)hipGetDevice(&dev); (void)hipDeviceGetAttribute(&cus, hipDeviceAttributeMultiprocessorCount, dev);
#if MK_COOP
        if (hipFuncSetAttribute((const void*)mk_fwd, hipFuncAttributeMaxDynamicSharedMemorySize, LDS_BYTES) != hipSuccess) { fprintf(stderr, "kernel_launch: hipFuncSetAttribute failed\n"); grid = -1; return; }
#else
        (void)hipFuncSetAttribute((const void*)k_ph<0>, hipFuncAttributeMaxDynamicSharedMemorySize, LDS_BYTES); (void)hipFuncSetAttribute((const void*)k_ph<1>, hipFuncAttributeMaxDynamicSharedMemorySize, LDS_BYTES);
        (void)hipFuncSetAttribute((const void*)k_ph<2>, hipFuncAttributeMaxDynamicSharedMemorySize, LDS_BYTES); (void)hipFuncSetAttribute((const void*)k_ph<3>, hipFuncAttributeMaxDynamicSharedMemorySize, LDS_BYTES);
        (void)hipFuncSetAttribute((const void*)k_ph<4>, hipFuncAttributeMaxDynamicSharedMemorySize, LDS_BYTES); (void)hipFuncSetAttribute((const void*)k_ph<5>, hipFuncAttributeMaxDynamicSharedMemorySize, LDS_BYTES);
        (void)hipFuncSetAttribute((const void*)k_ph<6>, hipFuncAttributeMaxDynamicSharedMemorySize, LDS_BYTES);
#endif
        if (hipOccupancyMaxActiveBlocksPerMultiprocessor(&per_cu, (const void*)MK_KERNEL, 512, LDS_BYTES) != hipSuccess || per_cu < 1) { fprintf(stderr, "kernel_launch: occupancy query gave %d\n", per_cu); per_cu = 1; }
        (void)hipGetLastError();
        grid = cus * per_cu;
    }
    if (grid < 0) return;
    Params p{};
    const float* const* in = (const float* const*)d_in;
    p.x = in[0]; p.norm_g = in[1]; p.w_in = in[2]; p.mu_a = in[3]; p.w_up = in[4]; p.w0 = in[5]; p.a_up = in[6]; p.a0 = in[7]; p.k_k = in[8]; p.k_a = in[9]; p.r_k = in[10];
    p.gn_g = in[11]; p.gn_b = in[12]; p.pool_w = in[13]; p.pool_scale = in[14]; p.qn_g = in[15]; p.kn_g = in[16]; p.w_out = in[17];
    p.out = (float*)d_out;
    unsigned char* ws = (unsigned char*)d_ws; size_t off = 0;
    auto take = [&](size_t bytes) { unsigned char* q = ws + off; off += (bytes + 255) & ~(size_t)255; return q; };
    p.W1 = (u16*)take((size_t)NPJ * DM * 2); p.W2 = (u16*)take((size_t)DM * DM * 2); p.HB = (u16*)take((size_t)MTOK * DM * 2); p.PJ = (u16*)take((size_t)MTOK * NPJ * 2);
    p.KR = (u16*)take((size_t)48 * SEQ * 256 * 2); p.VF = (u16*)take((size_t)48 * SEQ * 64 * 2); p.GH = (u16*)take((size_t)48 * 64 * 8192 * 2);
    p.WUT = (u16*)take(768 * 64 * 2); p.AUT = (u16*)take(768 * 64 * 2); p.PWT = (u16*)take(4 * 128 * 128 * 2);
    p.GC = (float*)take((size_t)48 * 64 * 64 * 4); p.SBN = (float*)take((size_t)MTOK * NH * 4); p.BAR = (unsigned*)take(XCD_BAR_WORDS * 4);
    if (off > ws_size) { fprintf(stderr, "kernel_launch: workspace too small: need %zu, have %zu\n", off, ws_size); return; }
    if (hipMemsetAsync(p.BAR, 0, XCD_BAR_WORDS * 4, stream) != hipSuccess) { fprintf(stderr, "kernel_launch: memset of the barrier words failed\n"); return; }
#if MK_COOP
    int lo = 0, hi = 12;
    void* args[] = {&p, &lo, &hi};
    hipError_t e = hipLaunchCooperativeKernel((const void*)mk_fwd, dim3(grid), dim3(512), args, LDS_BYTES, stream);
    if (e != hipSuccess) fprintf(stderr, "cooperative launch failed: %s (grid %d)\n", hipGetErrorString(e), grid);
#else
    for (int l = 0; l < 2; ++l) {
        hipLaunchKernelGGL(k_ph<0>, dim3(grid), dim3(512), LDS_BYTES, stream, p, l);
        hipLaunchKernelGGL(k_ph<1>, dim3(grid), dim3(512), LDS_BYTES, stream, p, l);
        hipLaunchKernelGGL(k_ph<2>, dim3(grid), dim3(512), LDS_BYTES, stream, p, l);
        hipLaunchKernelGGL(k_ph<3>, dim3(grid), dim3(512), LDS_BYTES, stream, p, l);
        hipLaunchKernelGGL(k_ph<4>, dim3(grid), dim3(512), LDS_BYTES, stream, p, l);
        hipLaunchKernelGGL(k_ph<5>, dim3(grid), dim3(512), LDS_BYTES, stream, p, l);
        hipLaunchKernelGGL(k_ph<6>, dim3(grid), dim3(512), LDS_BYTES, stream, p, l);
    }
#endif
}
```

```cpp
#include <hip/hip_runtime.h>
#include <hip/hip_cooperative_groups.h>
#include <cstdio>
namespace cg = cooperative_groups;
__device__ __forceinline__ int otid() { int t = threadIdx.x; asm volatile("" : "+v"(t)); return t; }
__device__ __forceinline__ int obid() { int b = blockIdx.x; asm volatile("" : "+s"(b)); return b; }
#ifndef MK_COOP
#define MK_COOP 1
#endif
namespace pg8 {
#define PG8_LAS __attribute__((address_space(3)))
typedef unsigned short bf16_t;
typedef short bf16x8 __attribute__((ext_vector_type(8)));
typedef float f32x4 __attribute__((ext_vector_type(4)));
typedef unsigned u32x4 __attribute__((ext_vector_type(4)));
constexpr int BM = 256, BK = 64, HALF = 128, HTB = HALF * BK * 2  , STAGE_BYTES = 8 * HTB, NXCD = 8, WGM = 8;

__host__ __device__ __forceinline__ int lds_byte(int r, int c) { const int st = (r >> 4) * 2 + (c >> 5), rr = r & 15, cc = c & 31, ob = rr * 64 + cc * 2; return st * 1024 + (ob ^ (((ob >> 9) & 1) << 5)); }
__host__ __device__ __forceinline__ void stage_rc(int b, int& R, int& C) { const int st = b / 1024, sb = b % 1024, swz = sb ^ (((sb >> 9) & 1) << 5); R = (st >> 1) * 16 + swz / 64; C = (st & 1) * 32 + (swz % 64) / 2; }
__host__ __device__ __forceinline__ int perm32(int rho) { const int n = rho >> 4, i = rho & 15; return 8 * (i >> 2) + 4 * n + (i & 3); }

struct Unit { int pm, pn; };
struct Gemm { const bf16_t* A; const bf16_t* Bt; int M, N, K; };
struct StaticOrder {
    int nM, nN, nwg, G, c;
    __host__ __device__ void init(int M, int N, int G_, int c_) { nM = M / BM; nN = N / BM; nwg = nM * nN; G = G_; c = c_; }
    __host__ __device__ bool next(int i, Unit& u) const {
        const long L = (long)i * G + c; if (L >= nwg) return false;
        int wgid = (int)L; { const int q = nwg / NXCD, r = nwg % NXCD, xcd = wgid % NXCD, off = wgid / NXCD; wgid = (xcd < r ? xcd * (q + 1) : r * (q + 1) + (xcd - r) * q) + off; }
        const int nig = WGM * nN, gid = wgid / nig, fm = gid * WGM, gsz = (nM - fm) < WGM ? (nM - fm) : WGM;
        u.pm = fm + ((wgid % nig) % gsz); u.pn = (wgid % nig) / gsz; return true;
    }
    __device__ __forceinline__ void a_ready(const Unit&) const {}
    __device__ __forceinline__ void done(const Unit&) const {}
};
__device__ __forceinline__ unsigned cvt_pk_bf16(float lo, float hi) { unsigned r; asm volatile("v_cvt_pk_bf16_f32 %0, %1, %2" : "=v"(r) : "v"(lo), "v"(hi)); return r; }
struct EpiBf16 {
    static constexpr bool PERM = true, AFTER_DRAIN = false;
    bf16_t* O; int ldc;
    __device__ __forceinline__ void operator()(const f32x4 (&acc)[2][2][4][2], const Unit& u, int wr, int wc, int fr, int fq) const {
        const int row0 = u.pm * BM + wr * 64 + fr; const int col0 = u.pn * BM + wc * 32 + 8 * fq;
#pragma unroll
        for (int ai = 0; ai < 2; ++ai)
#pragma unroll
            for (int m = 0; m < 4; ++m) { bf16_t* rowp = O + (size_t)(row0 + ai * HALF + m * 16) * ldc + col0;
#pragma unroll
                for (int bj = 0; bj < 2; ++bj) { const f32x4 v0 = acc[ai][bj][m][0], v1 = acc[ai][bj][m][1];
                    u32x4 w; w.x = cvt_pk_bf16(v0[0], v0[1]); w.y = cvt_pk_bf16(v0[2], v0[3]); w.z = cvt_pk_bf16(v1[0], v1[1]); w.w = cvt_pk_bf16(v1[2], v1[3]);
                    *(u32x4*)(rowp + bj * HALF) = w; } }
    }
};
struct EpiRes {
    static constexpr bool PERM = false, AFTER_DRAIN = false;
    const float* R; float* C; int ldc;
    __device__ __forceinline__ void operator()(const f32x4 (&acc)[2][2][4][2], const Unit& u, int wr, int wc, int fr, int fq) const {
        const int row0 = u.pm * BM + wr * 64 + fr, col0 = u.pn * BM + wc * 32 + 4 * fq;
#pragma unroll
        for (int ai = 0; ai < 2; ++ai)
#pragma unroll
            for (int mp = 0; mp < 2; ++mp) {
                f32x4 rr[2][2][2];
#pragma unroll
                for (int mm = 0; mm < 2; ++mm) { const size_t off = (size_t)(row0 + ai * HALF + (2 * mp + mm) * 16) * ldc + col0;
#pragma unroll
                    for (int bj = 0; bj < 2; ++bj)
#pragma unroll
                        for (int n = 0; n < 2; ++n) rr[mm][bj][n] = *(const f32x4*)(R + off + bj * HALF + n * 16); }
#pragma unroll
                for (int mm = 0; mm < 2; ++mm) { const size_t off = (size_t)(row0 + ai * HALF + (2 * mp + mm) * 16) * ldc + col0;
#pragma unroll
                    for (int bj = 0; bj < 2; ++bj)
#pragma unroll
                        for (int n = 0; n < 2; ++n) *(f32x4*)(C + off + bj * HALF + n * 16) = acc[ai][bj][2 * mp + mm][n] + rr[mm][bj][n]; }
            }
    }
};
template <class Epi, class Sched>
__device__ __forceinline__ void gemm_phase(PG8_LAS unsigned char* lds, const Gemm g, const Sched& S, const Epi& E) {
    const int tid = otid(), wid = __builtin_amdgcn_readfirstlane(tid >> 6), lane = tid & 63, wr = wid >> 2, wc = wid & 3, fr = lane & 15, fq = lane >> 4;
    const int K = g.K, nt = K / BK;
    unsigned voffA[2], voffB[2];
#pragma unroll
    for (int i = 0; i < 2; ++i) { int R, C; stage_rc(tid * 16 + i * 8192, R, C); const int Rb = Epi::PERM ? ((R & ~31) + perm32(R & 31)) : R;
        voffA[i] = (unsigned)(R * K + C) * 2u; voffB[i] = (unsigned)(Rb * K + C) * 2u; }
    const size_t kstep = (size_t)(BK * 2);
    const size_t hstep = (size_t)HALF * K * 2;
    const size_t tstep = 2 * hstep;
    const unsigned ldsw = (unsigned)wid * 1024u;
    const int aoff = lds_byte(wr * 64 + fr, fq * 8), boff = lds_byte(wc * 32 + fr, fq * 8);
#define PG8_SA(b, h) (((b) * 2 + (h)) * HTB)
#define PG8_SB(b, h) ((4 + (b) * 2 + (h)) * HTB)
#define PG8_STAGE(bufoff, gbase, voff) do { _Pragma("unroll") for (int _i = 0; _i < 2; ++_i) \
        __builtin_amdgcn_global_load_lds((const unsigned*)((const char*)(gbase) + (voff)[_i]), (PG8_LAS unsigned*)(lds + (bufoff) + ldsw + _i * 8192), 16, 0, 0); } while (0)
#define PG8_LDA(dst, b, h) do { _Pragma("unroll") for (int m = 0; m < 4; ++m) _Pragma("unroll") for (int k = 0; k < 2; ++k) dst[m][k] = *(const PG8_LAS bf16x8*)(lds + PG8_SA(b, h) + aoff + m * 2048 + k * 1024); } while (0)
#define PG8_LDB(dst, b, h) do { _Pragma("unroll") for (int n = 0; n < 2; ++n) _Pragma("unroll") for (int k = 0; k < 2; ++k) dst[n][k] = *(const PG8_LAS bf16x8*)(lds + PG8_SB(b, h) + boff + n * 2048 + k * 1024); } while (0)
#define PG8_MMA(ai, bj, At, Bt) do { __builtin_amdgcn_s_setprio(1); _Pragma("unroll") for (int m = 0; m < 4; ++m) _Pragma("unroll") for (int n = 0; n < 2; ++n) _Pragma("unroll") for (int k = 0; k < 2; ++k) \
        acc[ai][bj][m][n] = __builtin_amdgcn_mfma_f32_16x16x32_bf16(Bt[n][k], At[m][k], acc[ai][bj][m][n], 0, 0, 0); __builtin_amdgcn_s_setprio(0); } while (0)
#define PG8_WAIT_V(n) asm volatile("s_waitcnt vmcnt(" #n ")" ::: "memory")
#define PG8_WAIT_L(n) asm volatile("s_waitcnt lgkmcnt(" #n ")" ::: "memory")
#define PG8_BAR __builtin_amdgcn_s_barrier()
#define PG8_SCHED __builtin_amdgcn_sched_barrier(0)
    Unit cur, nxt; int ui = 0;
    if (!S.next(0, cur)) return;
    f32x4 acc[2][2][4][2];
#pragma unroll
    for (int a = 0; a < 2; ++a)
#pragma unroll
        for (int b = 0; b < 2; ++b)
#pragma unroll
            for (int m = 0; m < 4; ++m)
#pragma unroll
                for (int n = 0; n < 2; ++n) acc[a][b][m][n] = (f32x4){0.f, 0.f, 0.f, 0.f};
    bf16x8 At[4][2], B0[2][2], B1[2][2];
    const char* cA = (const char*)g.A + (size_t)cur.pm * tstep; const char* cB = (const char*)g.Bt + (size_t)cur.pn * tstep;
    S.a_ready(cur);
    PG8_STAGE(PG8_SB(0, 0), cB, voffB); PG8_STAGE(PG8_SA(0, 0), cA, voffA); PG8_STAGE(PG8_SB(0, 1), cB + hstep, voffB); PG8_STAGE(PG8_SA(0, 1), cA + hstep, voffA);
    if (wr == 1) PG8_BAR;
    PG8_WAIT_V(4); PG8_BAR;
    PG8_STAGE(PG8_SB(1, 0), cB + kstep, voffB); PG8_STAGE(PG8_SA(1, 0), cA + kstep, voffA); PG8_STAGE(PG8_SB(1, 1), cB + hstep + kstep, voffB);
    PG8_WAIT_V(6); PG8_BAR;
    for (;;) {
        const bool has_next = S.next(ui + 1, nxt);
        const char* nA = has_next ? (const char*)g.A + (size_t)nxt.pm * tstep : cA; const char* nB = has_next ? (const char*)g.Bt + (size_t)nxt.pn * tstep : cB;
        for (int t = 0; t < nt; t += 2) {
            const bool last = (t == nt - 2);
            const char* a1 = cA + (size_t)(t + 1) * kstep;
            const char* a2 = last ? nA : cA + (size_t)(t + 2) * kstep; const char* b2 = last ? nB : cB + (size_t)(t + 2) * kstep;
            const char* a3 = a2 + kstep; const char* b3 = b2 + kstep;
            if (last && has_next) S.a_ready(nxt);
            PG8_LDB(B0, 0, 0); PG8_SCHED; PG8_LDA(At, 0, 0); PG8_STAGE(PG8_SA(1, 1), a1 + hstep, voffA);
            PG8_WAIT_L(8); PG8_BAR; PG8_WAIT_L(0); PG8_MMA(0, 0, At, B0); PG8_BAR; PG8_SCHED;
            PG8_LDB(B1, 0, 1); PG8_STAGE(PG8_SB(0, 0), b2, voffB);
            PG8_BAR; PG8_WAIT_L(0); PG8_MMA(0, 1, At, B1); PG8_BAR;
            PG8_LDA(At, 0, 1); PG8_STAGE(PG8_SA(0, 0), a2, voffA);
            PG8_BAR; PG8_WAIT_L(0); PG8_MMA(1, 0, At, B0); PG8_BAR; PG8_SCHED;
            PG8_STAGE(PG8_SB(0, 1), b2 + hstep, voffB);
            PG8_WAIT_V(6); PG8_BAR; PG8_MMA(1, 1, At, B1); PG8_BAR;
            PG8_LDB(B0, 1, 0); PG8_SCHED; PG8_LDA(At, 1, 0); PG8_STAGE(PG8_SA(0, 1), a2 + hstep, voffA);
            PG8_WAIT_L(8); PG8_BAR; PG8_WAIT_L(0); PG8_MMA(0, 0, At, B0); PG8_BAR; PG8_SCHED;
            PG8_LDB(B1, 1, 1); PG8_STAGE(PG8_SB(1, 0), b3, voffB);
            PG8_BAR; PG8_WAIT_L(0); PG8_MMA(0, 1, At, B1); PG8_BAR;
            PG8_LDA(At, 1, 1); PG8_STAGE(PG8_SA(1, 0), a3, voffA);
            PG8_BAR; PG8_WAIT_L(0); PG8_MMA(1, 0, At, B0); PG8_BAR; PG8_SCHED;
            PG8_STAGE(PG8_SB(1, 1), b3 + hstep, voffB);
            PG8_WAIT_V(6); PG8_BAR; PG8_MMA(1, 1, At, B1); PG8_BAR;
        }
        if constexpr (!Epi::AFTER_DRAIN) { E(acc, cur, wr, wc, fr, fq); S.done(cur); }
        if (!has_next) break;
#pragma unroll
        for (int a = 0; a < 2; ++a)
#pragma unroll
            for (int b = 0; b < 2; ++b)
#pragma unroll
                for (int m = 0; m < 4; ++m)
#pragma unroll
                    for (int n = 0; n < 2; ++n) acc[a][b][m][n] = (f32x4){0.f, 0.f, 0.f, 0.f};
        cur = nxt; cA = nA; cB = nB; ++ui;
    }
    PG8_WAIT_V(0);
    if (wr == 0) PG8_BAR;
    PG8_BAR;
    if constexpr (Epi::AFTER_DRAIN) { E.fused(acc, cur, wr, wc, fr, fq, lds, wid, lane); S.done(cur); }
#undef PG8_SA
#undef PG8_SB
#undef PG8_STAGE
#undef PG8_LDA
#undef PG8_LDB
#undef PG8_MMA
#undef PG8_WAIT_V
#undef PG8_WAIT_L
#undef PG8_BAR
#undef PG8_SCHED
}
}
#define XB_TMO      128
#define XB_XCNT(j)  (256  + 64 * (j))
#define XB_XSUB(j)  (1280 + 64 * (j))
#define XB_XGEN(j)  (2304 + 64 * (j))
#define XB_TOP      3328
#define XB_TOPGEN   3392
#define XCD_BAR_WORDS 3456
#define XB_SPIN_CAP (1u << 18)
#define LAS __attribute__((address_space(3)))

__device__ __forceinline__ unsigned xb_ld(unsigned* p)              { return __hip_atomic_load(p, __ATOMIC_RELAXED, __HIP_MEMORY_SCOPE_AGENT); }
__device__ __forceinline__ unsigned xb_add(unsigned* p, unsigned v) { return __hip_atomic_fetch_add(p, v, __ATOMIC_RELAXED, __HIP_MEMORY_SCOPE_AGENT); }
__device__ __forceinline__ unsigned xb_xcc_id() { return (unsigned)__builtin_amdgcn_s_getreg((3 << 11) | 20) & 0xFu; }
#define XB_SPIN(cond, bar) do { unsigned _sp = 0; while (cond) { __builtin_amdgcn_s_sleep(1); \
    if ((++_sp & 255u) == 0u) { if (xb_ld(&(bar)[XB_TMO])) break; if (_sp > XB_SPIN_CAP) { atomicAdd(&(bar)[XB_TMO], 1u); break; } } } } while (0)
struct XcdBarrier {
    unsigned* bar; unsigned x;
    volatile LAS unsigned* st;
};

__device__ __forceinline__ XcdBarrier xcd_barrier_post(unsigned* bar, volatile LAS unsigned* st) {
    XcdBarrier b; b.bar = bar; b.x = xb_xcc_id(); b.st = st;
    if (threadIdx.x == 0) (void)xb_add(&bar[XB_XCNT(b.x)], 1u);
    return b;
}
__device__ __forceinline__ void xcd_barrier_complete(unsigned* bar, unsigned x, unsigned& nloc, unsigned& nx) {
    const unsigned G = gridDim.x * gridDim.y * gridDim.z;
    unsigned sum, cnt, mine, sp = 0u;
    for (;;) {
        sum = 0u; cnt = 0u; mine = 0u;
#pragma unroll
        for (unsigned j = 0; j < 16; ++j) { const unsigned c = xb_ld(&bar[XB_XCNT(j)]); sum += c; cnt += (c > 0u) ? 1u : 0u; mine = (j == x) ? c : mine; }
        if (sum == G) break;
        __builtin_amdgcn_s_sleep(1);
        if ((++sp & 255u) == 0u) { if (xb_ld(&bar[XB_TMO])) break; if (sp > XB_SPIN_CAP) { atomicAdd(&bar[XB_TMO], 1u); break; } }
    }
    nloc = mine > 0u ? mine : 1u; nx = cnt > 0u ? cnt : 1u;
}

__device__ __forceinline__ void xcd_barrier(const XcdBarrier& b) {
    asm volatile("s_waitcnt vmcnt(0)" ::: "memory");
    __syncthreads();
    if (threadIdx.x == 0) {
        unsigned* bar = b.bar;
        __builtin_amdgcn_s_waitcnt(0);
        unsigned nloc = b.st[0], nx = b.st[1];
        if (nloc == 0u) { xcd_barrier_complete(bar, b.x, nloc, nx); b.st[0] = nloc; b.st[1] = nx; }
        const unsigned old = xb_add(&bar[XB_XSUB(b.x)], 1u);
        const unsigned gen = old / nloc;
        if (old + 1u == (gen + 1u) * nloc) {
            __builtin_amdgcn_fence(__ATOMIC_RELEASE, "agent");
            asm volatile("s_waitcnt vmcnt(0)" ::: "memory");
            const unsigned og = xb_add(&bar[XB_TOP], 1u);
            const unsigned tg = og / nx;
            if (og + 1u == (tg + 1u) * nx) xb_add(&bar[XB_TOPGEN], 1u);
            else XB_SPIN(xb_ld(&bar[XB_TOPGEN]) == tg, bar);
            __builtin_amdgcn_fence(__ATOMIC_ACQUIRE, "agent");
            xb_add(&bar[XB_XGEN(b.x)], 1u);
            asm volatile("s_waitcnt vmcnt(0)" ::: "memory");
        } else {
            XB_SPIN(xb_ld(&bar[XB_XGEN(b.x)]) == gen, bar);
            __builtin_amdgcn_fence(__ATOMIC_ACQUIRE, "agent");
            asm volatile("s_waitcnt vmcnt(0)" ::: "memory");
        }
    }
    __syncthreads();
}

typedef unsigned short u16;
typedef short bf16x8 __attribute__((ext_vector_type(8)));
typedef float f32x16 __attribute__((ext_vector_type(16)));
#define DI __device__ __forceinline__
constexpr int MTOK = 16384, SEQ = 4096, DM = 2048, NPJ = 7424, NIN = 7296, NH = 12, NG1 = 7168;
constexpr int C_R = 0, C_K = 768, C_V = 1536, C_G = 2304, C_WD = 3072, C_PU = 3200, C_PG = 3712, C_AQ = 4224, C_AK = 4992, C_AV = 5760, C_AG = 6528;
constexpr int LDS_BYTES = 148 * 1024 + 64;

struct Params {
    const float *x, *norm_g, *w_in, *mu_a, *w_up, *w0, *a_up, *a0, *k_k, *k_a, *r_k, *gn_g, *gn_b, *pool_w, *pool_scale, *qn_g, *kn_g, *w_out;
    float* out;
    u16 *W1, *W2, *HB, *PJ, *KR, *VF, *GH, *WUT, *AUT, *PWT;
    float *GC, *SBN;
    unsigned* BAR;
};

DI float bf2f(u16 b) { return __uint_as_float(((unsigned)b) << 16); }
typedef __bf16 hwbf16x2 __attribute__((ext_vector_type(2)));
typedef float hwf32x2 __attribute__((ext_vector_type(2)));
DI unsigned pk2(float lo, float hi) { const hwf32x2 f = {lo, hi}; return __builtin_bit_cast(unsigned, __builtin_convertvector(f, hwbf16x2)); }
DI u16 f2bf(float f) { return (u16)(pk2(f, 0.f) & 0xffffu); }
DI float bflo(unsigned u) { return __uint_as_float(u << 16); }
DI float bfhi(unsigned u) { return __uint_as_float(u & 0xffff0000u); }
DI float silu(float x) { return x / (1.f + __expf(-x)); }
DI float wave_sum(float v) {
#pragma unroll
    for (int o = 32; o > 0; o >>= 1) v += __shfl_xor(v, o);
    return v;
}
template <int CTRL> DI float dpp_mov(float x) { return __builtin_bit_cast(float, __builtin_amdgcn_update_dpp(0, __builtin_bit_cast(int, x), CTRL, 0xf, 0xf, false)); }
DI float row16_sum(float x) {
    x += dpp_mov<0xB1>(x); x += dpp_mov<0x4E>(x); x += dpp_mov<0x141>(x); x += dpp_mov<0x140>(x); return x;
}

constexpr int ILD = 72, IMG = 64 * ILD;
DI f32x16 f16zero() { f32x16 z;
#pragma unroll
    for (int i = 0; i < 16; ++i) z[i] = 0.f; return z; }

DI void convert_weights(const Params& p, int l, unsigned char* shm, int u0, int ustride, int ubeg, int uend) {
    const int tid = otid();
    float* sT = (float*)shm;
    const float* win = p.w_in + (size_t)l * DM * NIN;
    const float* wout = p.w_out + (size_t)l * DM * DM;
    const int nW1 = 32 * (NPJ / 256);
    float4 v0, v1, v2, v3, v4, v5, v6, v7;
    auto ldv = [&](int u, int i) __attribute__((always_inline)) -> float4 {
        const float* src; int N, kt, nt;
        if (u < nW1) { kt = u & 31; nt = u >> 5; src = win; N = NIN; } else { const int w2 = u - nW1; kt = w2 & 31; nt = w2 >> 5; src = wout; N = DM; }
        const int kk = (tid >> 6) + 8 * i, nn = (tid & 63) * 4;
        float4 r = make_float4(0.f, 0.f, 0.f, 0.f);
        if (nt * 256 + nn < N) { typedef float vf4 __attribute__((ext_vector_type(4)));
            const vf4 t = __builtin_nontemporal_load((const vf4*)(src + (size_t)(kt * 64 + kk) * N + nt * 256 + nn)); r = make_float4(t[0], t[1], t[2], t[3]); }
        return r;
    };
#define CW_LOAD(U) do { v0 = ldv(U, 0); v1 = ldv(U, 1); v2 = ldv(U, 2); v3 = ldv(U, 3); v4 = ldv(U, 4); v5 = ldv(U, 5); v6 = ldv(U, 6); v7 = ldv(U, 7); } while (0)
#define CW_PARK(I, V) do { const int kk = (tid >> 6) + 8 * (I), nn = (tid & 63) * 4; sT[kk * 257 + nn + 0] = V.x; sT[kk * 257 + nn + 1] = V.y; sT[kk * 257 + nn + 2] = V.z; sT[kk * 257 + nn + 3] = V.w; } while (0)
    if (ubeg + u0 < uend) CW_LOAD(ubeg + u0);
    for (int u = ubeg + u0; u < uend; u += ustride) {
        u16* dst; int kt, nt;
        if (u < nW1) { kt = u & 31; nt = u >> 5; dst = p.W1; } else { const int w2 = u - nW1; kt = w2 & 31; nt = w2 >> 5; dst = p.W2; }
        const int k0 = kt * 64, n0 = nt * 256;
        CW_PARK(0, v0); CW_PARK(1, v1); CW_PARK(2, v2); CW_PARK(3, v3); CW_PARK(4, v4); CW_PARK(5, v5); CW_PARK(6, v6); CW_PARK(7, v7);
        __syncthreads();
        if (u + ustride < uend) CW_LOAD(u + ustride);
        {
            const int nn = tid >> 1, ks = (tid & 1) * 32;
#pragma unroll
            for (int c4 = 0; c4 < 4; ++c4) {
                const int kb = ks + c4 * 8;
                uint4 o;
                o.x = pk2(sT[(kb + 0) * 257 + nn], sT[(kb + 1) * 257 + nn]); o.y = pk2(sT[(kb + 2) * 257 + nn], sT[(kb + 3) * 257 + nn]);
                o.z = pk2(sT[(kb + 4) * 257 + nn], sT[(kb + 5) * 257 + nn]); o.w = pk2(sT[(kb + 6) * 257 + nn], sT[(kb + 7) * 257 + nn]);
                *(uint4*)(dst + (size_t)(n0 + nn) * DM + k0 + kb) = o;
            }
        }
        __syncthreads();
    }
#undef CW_LOAD
#undef CW_PARK
}

DI void phase_p1(const Params& p, int l, unsigned char* shm) {
    const int tid = otid(), wave = tid >> 6, lane = tid & 63;
    const int nW1 = 32 * (NPJ / 256), nW2 = 32 * (DM / 256);
    const float* xin = l == 0 ? p.x : p.out;
    const float* g = p.norm_g + l * DM;
    float4 gq[8];
#pragma unroll
    for (int i = 0; i < 8; ++i) gq[i] = *(const float4*)(g + i * 256 + lane * 4);
    const int rstep = gridDim.x * 16;
    int row = (obid() * 8 + wave) * 2;
    float4 v[16];
    if (row < MTOK) {
#pragma unroll
        for (int i = 0; i < 16; ++i) v[i] = *(const float4*)(xin + (size_t)(row + (i >> 3)) * DM + (i & 7) * 256 + lane * 4);
    }
    convert_weights(p, l, shm, obid(), gridDim.x, l == 0 ? 0 : nW1, nW1 + nW2);
    {
        const float* w_up = p.w_up + l * 64 * 768; const float* a_up = p.a_up + l * 64 * 768; const float* pool_w = p.pool_w + (size_t)l * 4 * 128 * 128;
        for (int e = obid() * 512 + tid; e < 768 * 64; e += gridDim.x * 512) { const int c = e >> 6, j = e & 63; p.WUT[e] = f2bf(w_up[j * 768 + c]); p.AUT[e] = f2bf(a_up[j * 768 + c]); }
        for (int e = obid() * 512 + tid; e < 4 * 128 * 128; e += gridDim.x * 512) { const int g2 = e >> 14, dd = (e >> 7) & 127, c = e & 127; p.PWT[e] = f2bf(pool_w[(g2 * 128 + c) * 128 + dd]); }
    }
#pragma unroll 1
    for (; row < MTOK; row += rstep) {
        float4 vn[16];
        const int rown = row + rstep;
        if (rown < MTOK) {
#pragma unroll
            for (int i = 0; i < 16; ++i) vn[i] = *(const float4*)(xin + (size_t)(rown + (i >> 3)) * DM + (i & 7) * 256 + lane * 4);
        }
        float ss0 = 0.f, ss1 = 0.f;
#pragma unroll
        for (int i = 0; i < 8; ++i) { ss0 += v[i].x * v[i].x + v[i].y * v[i].y + v[i].z * v[i].z + v[i].w * v[i].w; ss1 += v[8 + i].x * v[8 + i].x + v[8 + i].y * v[8 + i].y + v[8 + i].z * v[8 + i].z + v[8 + i].w * v[8 + i].w; }
        ss0 = wave_sum(ss0); ss1 = wave_sum(ss1);
        const float inv0 = rsqrtf(ss0 * (1.f / DM) + 1e-6f), inv1 = rsqrtf(ss1 * (1.f / DM) + 1e-6f);
#pragma unroll
        for (int i = 0; i < 16; ++i) {
            const float inv = (i < 8) ? inv0 : inv1;
            const float4 gg = gq[i & 7];
            uint2 o; o.x = pk2(v[i].x * inv * gg.x, v[i].y * inv * gg.y); o.y = pk2(v[i].z * inv * gg.z, v[i].w * inv * gg.w);
            *(uint2*)(p.HB + (size_t)(row + (i >> 3)) * DM + (i & 7) * 256 + lane * 4) = o;
        }
        if (rown < MTOK) {
#pragma unroll
            for (int i = 0; i < 16; ++i) v[i] = vn[i];
        }
    }
}

DI float wave_sum_fast(float x) {
    const int xi = __builtin_bit_cast(int, row16_sum(x));
    const float s0 = __builtin_bit_cast(float, __builtin_amdgcn_readlane(xi, 0)), s1 = __builtin_bit_cast(float, __builtin_amdgcn_readlane(xi, 16));
    const float s2 = __builtin_bit_cast(float, __builtin_amdgcn_readlane(xi, 32)), s3 = __builtin_bit_cast(float, __builtin_amdgcn_readlane(xi, 48));
    return (s0 + s1) + (s2 + s3);
}
DI float frcp(float x) { return __builtin_amdgcn_rcpf(x); }
DI void phase_p3(const Params& p, int l, unsigned char* shm) {
    const float* mu = p.mu_a + l * 3200;
    const float* w0 = p.w0 + l * 768; const float* a0 = p.a0 + l * 768; const float* k_k = p.k_k + l * 768; const float* k_a = p.k_a + l * 768; const float* r_k = p.r_k + l * 768;
    const float* pool_scale = p.pool_scale + l * 512;
    const float* qn_g = p.qn_g + l * 64; const float* kn_g = p.kn_g + l * 64;
    constexpr int DLD = 520;
    u16* sXW = (u16*)shm;
    u16* sXA = sXW + 32 * ILD;
    u16* sD = sXA + 32 * ILD;
    float* sLG = (float*)(sD + 32 * DLD);
    u16* sRAW = (u16*)(sLG + 768);
    u16* MIX = p.HB;
    for (int unit2 = obid() * 2; unit2 < MTOK / 32; unit2 += gridDim.x * 2)
    for (int sub = 0; sub < 2; ++sub) {
        if (sub == 0) {
            const int tid = otid(), wave = __builtin_amdgcn_readfirstlane(tid >> 6), lane = tid & 63, r = lane & 31, hh = lane >> 5;
            constexpr int TLD = 136;
            u16* sTA = (u16*)shm; u16* sTB = sTA + 64 * TLD;
            const int trw = wave >> 2, tcw = wave & 3;
            auto t0_src = [&](int jj, int kc) __attribute__((always_inline)) -> const u16* {
                const int idx = tid + 512 * (jj < 2 ? jj : jj - 2), row = idx >> 4, c16 = idx & 15;
                return (jj < 2) ? p.HB + (size_t)(unit2 * 32 + row) * DM + kc * 128 + c16 * 8 : p.W1 + (size_t)(NG1 + row) * DM + kc * 128 + c16 * 8;
            };
            constexpr int TBUF = 192 * TLD;
            auto t0_dst = [&](int jj, int buf) __attribute__((always_inline)) -> u16* {
                const int idx = tid + 512 * (jj < 2 ? jj : jj - 2), row = idx >> 4, c16 = idx & 15;
                return ((jj < 2) ? sTA : sTB) + buf * TBUF + row * TLD + c16 * 8;
            };
            uint4 pf0, pf1, pf2, pf3, pf4, pf5;
#define T0_ISSUE(KC) do { pf0 = *(const uint4*)t0_src(0, KC); pf1 = *(const uint4*)t0_src(1, KC); pf2 = *(const uint4*)t0_src(2, KC); pf3 = *(const uint4*)t0_src(3, KC); pf4 = *(const uint4*)t0_src(4, KC); pf5 = *(const uint4*)t0_src(5, KC); } while (0)
#define T0_PARK(BUF) do { *(uint4*)t0_dst(0, BUF) = pf0; *(uint4*)t0_dst(1, BUF) = pf1; *(uint4*)t0_dst(2, BUF) = pf2; *(uint4*)t0_dst(3, BUF) = pf3; *(uint4*)t0_dst(4, BUF) = pf4; *(uint4*)t0_dst(5, BUF) = pf5; } while (0)
            T0_ISSUE(0);
            T0_PARK(0);
            T0_ISSUE(1);
            __syncthreads();
            f32x16 z = f16zero();
#pragma unroll 1
            for (int kc = 0; kc < 16; ++kc) {
                const u16* cA = sTA + (kc & 1) * TBUF; const u16* cB = sTB + (kc & 1) * TBUF;
#pragma unroll 4
                for (int s = 0; s < 8; ++s) {
                    const bf16x8 a = *(const bf16x8*)(cA + (32 * trw + r) * TLD + 16 * s + 8 * hh), bq = *(const bf16x8*)(cB + (32 * tcw + r) * TLD + 16 * s + 8 * hh);
                    z = __builtin_amdgcn_mfma_f32_32x32x16_bf16(a, bq, z, 0, 0, 0);
                }
                if (kc + 1 < 16) { T0_PARK((kc + 1) & 1); if (kc + 2 < 16) T0_ISSUE(kc + 2); }
                __syncthreads();
            }
#undef T0_PARK
#undef T0_ISSUE
#pragma unroll
            for (int i = 0; i < 16; ++i) p.PJ[(size_t)(unit2 * 32 + 32 * trw + 8 * (i >> 2) + 4 * hh + (i & 3)) * NPJ + NG1 + 32 * tcw + r] = f2bf(z[i]);
        }
        const int tid = otid(), wave = __builtin_amdgcn_readfirstlane(tid >> 6), lane = tid & 63, r = lane & 31, hh = lane >> 5;
        u16* sSCR = sRAW + wave * 4096;
        const int unit = unit2 + sub;
        const int t0 = unit * 32, b = t0 >> 12, s0 = t0 & (SEQ - 1);
#pragma unroll
        for (int e = tid; e < 32 * 128; e += 512) {
            const int tok = e >> 7, j = e & 127, col = C_WD + j;
            const size_t row = (size_t)(t0 + tok);
            const float cur = bf2f(p.PJ[row * NPJ + col]);
            const float prv = (s0 + tok > 0) ? bf2f(p.PJ[(row - 1) * NPJ + col]) : 0.f;
            const float v = cur + (prv - cur) * mu[col];
            if (j < 64) sXW[tok * ILD + j] = f2bf(1.f - 2.f * frcp(1.f + __expf(2.f * v)));
            else sXA[tok * ILD + (j - 64)] = f2bf(v);
        }
#pragma unroll
        for (int e = tid; e < 47 * 64; e += 512) {
            const int rr = e >> 6, seg = (e & 63) * 8, s = s0 - 15 + rr;
            uint4 v = make_uint4(0u, 0u, 0u, 0u);
            if (s >= 0) v = *(const uint4*)(p.PJ + (size_t)(t0 - 15 + rr) * NPJ + C_PU + seg);
            *(uint4*)(sRAW + rr * 512 + seg) = v;
        }
        __syncthreads();
        {
            const int c = tid, win = 2 << (c >> 7);
            float raw[47];
#pragma unroll
            for (int i = 0; i < 47; ++i) raw[i] = bf2f(sRAW[i * 512 + c]);
            float run = 0.f;
#pragma unroll
            for (int j = 1; j < 16; ++j) run += (j < win) ? raw[15 - j] : 0.f;
#pragma unroll
            for (int tok = 0; tok < 32; ++tok) {
                const int s = s0 + tok; const int n = (s + 1 < win) ? (s + 1) : win;
                const float uu = raw[15 + tok];
                run += uu;
                sD[tok * DLD + c] = f2bf(run * frcp((float)n) - uu);
                const float o2 = raw[15 + tok - 1], o4 = raw[15 + tok - 3], o8 = raw[15 + tok - 7], o16 = raw[15 + tok - 15];
                run -= (win == 2) ? o2 : (win == 4) ? o4 : (win == 8) ? o8 : o16;
            }
        }
        __syncthreads();
#pragma unroll 1
        for (int rnd = 0; rnd < 2; ++rnd) {
            const int hd = rnd ? 8 + (wave & 3) : wave;
            const int segb = rnd ? (wave >> 2) : 0, sege = rnd ? segb + 1 : 2;
            {
#pragma unroll 1
                for (int mat = 0; mat < 2; ++mat) {
                    const u16* X = mat ? sXA : sXW; const u16* WT = mat ? p.AUT : p.WUT;
                    f32x16 z0 = f16zero(), z1 = f16zero();
#pragma unroll
                    for (int s = 0; s < 4; ++s) {
                        const bf16x8 xf = *(const bf16x8*)(X + r * ILD + 16 * s + 8 * hh);
                        const bf16x8 w0f = *(const bf16x8*)(WT + (size_t)(hd * 64 + r) * 64 + 16 * s + 8 * hh), w1f = *(const bf16x8*)(WT + (size_t)(hd * 64 + 32 + r) * 64 + 16 * s + 8 * hh);
                        z0 = __builtin_amdgcn_mfma_f32_32x32x16_bf16(xf, w0f, z0, 0, 0, 0); z1 = __builtin_amdgcn_mfma_f32_32x32x16_bf16(xf, w1f, z1, 0, 0, 0);
                    }
#pragma unroll
                    for (int i = 0; i < 16; ++i) {
                        const int tok = 8 * (i >> 2) + 4 * hh + (i & 3);
                        sSCR[mat * 2048 + tok * 64 + r] = f2bf(z0[i]); sSCR[mat * 2048 + tok * 64 + 32 + r] = f2bf(z1[i]);
                    }
                }
                __builtin_amdgcn_fence(__ATOMIC_RELEASE, "workgroup"); __builtin_amdgcn_wave_barrier(); __builtin_amdgcn_fence(__ATOMIC_ACQUIRE, "workgroup");
            }
            const int c = hd * 64 + lane, n = lane, bh = b * NH + hd;
            const float w0c = w0[c], a0c = a0[c], kkc = k_k[c], kac = k_a[c], rkc = r_k[c], mur = mu[C_R + c], muk = mu[C_K + c];
            float lg = sub ? sLG[c] : 0.f;
            const u16* pk = p.PJ + (size_t)t0 * NPJ + C_K + c; const u16* pr = p.PJ + (size_t)t0 * NPJ + C_R + c;
            float kp = 0.f, rp = 0.f;
            if (segb == 0) { if (s0 > 0) { kp = bf2f(*(pk - NPJ)); rp = bf2f(*(pr - NPJ)); } }
            else {
                kp = bf2f(pk[(size_t)15 * NPJ]); rp = bf2f(pr[(size_t)15 * NPJ]);
#pragma unroll
                for (int t = 0; t < 16; ++t) lg -= 0.60653066f * frcp(1.f + __expf(-(w0c + bf2f(sSCR[t * 64 + n]))));
            }
            float gprev = __expf(lg);
#pragma unroll 1
            for (int seg = segb; seg < sege; ++seg) {
                const int tb = seg * 16;
                unsigned krraw[16];
#pragma unroll
                for (int i = 0; i < 16; ++i) krraw[i] = (unsigned)pk[(size_t)(tb + i) * NPJ] | ((unsigned)pr[(size_t)(tb + i) * NPJ] << 16);
#pragma unroll
                for (int i = 0; i < 16; ++i) {
                    const int t = tb + i, s = s0 + t;
                    const float lw = w0c + bf2f(sSCR[t * 64 + n]);
                    const float ee = 0.60653066f * frcp(1.f + __expf(-lw));
                    const float a = frcp(1.f + __expf(-(a0c + bf2f(sSCR[2048 + t * 64 + n]))));
                    const float kc = bflo(krraw[i]), rc = bfhi(krraw[i]);
                    const float ks = kc + (kp - kc) * muk, rs = rc + (rp - rc) * mur;
                    kp = kc; rp = rc;
                    const float kkv = ks * kkc;
                    const float ss = wave_sum_fast(kkv * kkv);
                    const float kk = kkv * rsqrtf(fmaxf(ss, 1e-24f));
                    const float kprime = ks * (1.f + (a - 1.f) * kac);
                    const float kka = kk * a;
                    const float bon = wave_sum_fast(rs * kprime * rkc);
                    const size_t rec = (size_t)bh * SEQ + s;
                    lg -= ee;
                    const float gcur = __expf(lg), ig = frcp(gcur);
                    p.KR[(rec * 4 + 0) * 64 + n] = f2bf(-gprev * kk); p.KR[(rec * 4 + 1) * 64 + n] = f2bf(kka * ig);
                    p.KR[(rec * 4 + 2) * 64 + n] = f2bf(kprime * ig); p.KR[(rec * 4 + 3) * 64 + n] = f2bf(rs * gcur);
                    if ((s & 63) == 63) p.GC[((size_t)bh * 64 + (s >> 6)) * 64 + n] = gcur;
                    if (n == 0) p.SBN[(size_t)(t0 + t) * NH + hd] = bon;
                    gprev = gcur;
                }
            }
            if (sege == 2) sLG[c] = lg;
        }
#define B1_LOAD(VV, BT) do { _Pragma("unroll") for (int i3 = 0; i3 < 3; ++i3) { const int it = (BT) * 3 + i3; \
            const int f = it * 512 + tid, fl = f & 63, dblk = (f >> 6) & 1, ks = (f >> 7) & 1, h = f >> 8, hh2 = fl >> 5, r2 = fl & 31; \
            _Pragma("unroll") for (int jp = 0; jp < 4; ++jp) { const int j0 = 2 * jp, j1 = 2 * jp + 1; \
                const int key0 = 16 * ks + 8 * (j0 >> 2) + 4 * hh2 + (j0 & 3), key1 = 16 * ks + 8 * (j1 >> 2) + 4 * hh2 + (j1 & 3); \
                const unsigned a0v = p.PJ[(size_t)(t0 + key0) * NPJ + C_AV + h * 64 + dblk * 32 + r2]; \
                const unsigned a1v = p.PJ[(size_t)(t0 + key1) * NPJ + C_AV + h * 64 + dblk * 32 + r2]; \
                VV[i3][jp] = a0v | (a1v << 16); } } } while (0)
#define B1_STORE(VV, BT) do { _Pragma("unroll") for (int i3 = 0; i3 < 3; ++i3) { const int it = (BT) * 3 + i3; \
            const int f = it * 512 + tid, fl = f & 63, dblk = (f >> 6) & 1, ks = (f >> 7) & 1, h = f >> 8; \
            uint4 o; o.x = VV[i3][0]; o.y = VV[i3][1]; o.z = VV[i3][2]; o.w = VV[i3][3]; \
            *(uint4*)(p.VF + ((((size_t)(b * NH + h) * 128 + (s0 >> 5)) * 2 + ks) * 2 + dblk) * 512 + fl * 8) = o; } } while (0)
#define B2_LOAD(UA, UB, BT) do { _Pragma("unroll") for (int i3 = 0; i3 < 3; ++i3) { const int it = (BT) * 3 + i3; \
            const int ridx = it * 128 + (tid >> 2), part = tid & 3; \
            const int which = ridx >= 384 ? 1 : 0, rr = ridx - which * 384, tok = rr / NH, h = rr - tok * NH; \
            const u16* ptr = p.PJ + (size_t)(t0 + tok) * NPJ + (which ? C_AK : C_AQ) + h * 64 + part * 16; \
            UA[i3] = *(const uint4*)ptr; UB[i3] = *(const uint4*)(ptr + 8); } } while (0)
        unsigned vvA[3][4], vvB[3][4]; uint4 uaA[3], ubA[3], uaB[3], ubB[3];
        {
            unsigned gate[2][8]; f32x16 zz[2]; float sc2[2];
#pragma unroll
            for (int ti = 0; ti < 2; ++ti) {
                const int tile = wave * 2 + ti, g = tile >> 2, ct = tile & 3, chn = g * 128 + 32 * ct + r;
                sc2[ti] = pool_scale[chn];
#pragma unroll
                for (int i = 0; i < 16; i += 2) gate[ti][i >> 1] = (unsigned)p.PJ[(size_t)(t0 + 8 * (i >> 2) + 4 * hh + (i & 3)) * NPJ + C_PG + chn] | ((unsigned)p.PJ[(size_t)(t0 + 8 * (i >> 2) + 4 * hh + (i & 3) + 1) * NPJ + C_PG + chn] << 16);
            }
            B1_LOAD(vvA, 0);
#pragma unroll
            for (int ti = 0; ti < 2; ++ti) {
                const int tile = wave * 2 + ti, g = tile >> 2, ct = tile & 3;
                f32x16 z = f16zero();
#pragma unroll
                for (int s = 0; s < 8; ++s) {
                    const bf16x8 a = *(const bf16x8*)(sD + r * DLD + g * 128 + 16 * s + 8 * hh);
                    const bf16x8 bq = *(const bf16x8*)(p.PWT + (size_t)(g * 128 + 32 * ct + r) * 128 + 16 * s + 8 * hh);
                    z = __builtin_amdgcn_mfma_f32_32x32x16_bf16(a, bq, z, 0, 0, 0);
                }
                zz[ti] = z;
            }
#pragma unroll
            for (int ti = 0; ti < 2; ++ti) {
                const int tile = wave * 2 + ti, g = tile >> 2, ct = tile & 3, chn = g * 128 + 32 * ct + r;
#pragma unroll
                for (int i = 0; i < 16; ++i) {
                    const size_t row = (size_t)(t0 + 8 * (i >> 2) + 4 * hh + (i & 3));
                    const float gt = (i & 1) ? bfhi(gate[ti][i >> 1]) : bflo(gate[ti][i >> 1]);
                    MIX[row * DM + 768 + chn] = f2bf(zz[ti][i] * sc2[ti] * silu(gt));
                }
            }
        }
        B1_STORE(vvA, 0);
        B1_LOAD(vvB, 1); B2_LOAD(uaA, ubA, 0);
        B1_STORE(vvB, 1);
        B2_LOAD(uaB, ubB, 1);
        {
#pragma unroll
            for (int i3 = 0; i3 < 3; ++i3) {
                const int it = 0 * 3 + i3;
                const int ridx = it * 128 + (tid >> 2), part = tid & 3;
                const int which = ridx >= 384 ? 1 : 0, rr = ridx - which * 384, tok = rr / NH, h = rr - tok * NH;
                u16* ptr = p.PJ + (size_t)(t0 + tok) * NPJ + (which ? C_AK : C_AQ) + h * 64 + part * 16;
                const uint4 u0 = uaA[i3], u1 = ubA[i3];
                float xv[16];
                xv[0] = bflo(u0.x); xv[1] = bfhi(u0.x); xv[2] = bflo(u0.y); xv[3] = bfhi(u0.y); xv[4] = bflo(u0.z); xv[5] = bfhi(u0.z); xv[6] = bflo(u0.w); xv[7] = bfhi(u0.w);
                xv[8] = bflo(u1.x); xv[9] = bfhi(u1.x); xv[10] = bflo(u1.y); xv[11] = bfhi(u1.y); xv[12] = bflo(u1.z); xv[13] = bfhi(u1.z); xv[14] = bflo(u1.w); xv[15] = bfhi(u1.w);
                float ss = 0.f;
#pragma unroll
                for (int i = 0; i < 16; ++i) ss += xv[i] * xv[i];
                ss += __shfl_xor(ss, 1); ss += __shfl_xor(ss, 2);
                const float inv = rsqrtf(ss * (1.f / 64.f) + 1e-6f) * (which ? 1.f : 0.125f * 1.44269504089f);
                const float* gg = (which ? kn_g : qn_g) + part * 16;
#pragma unroll
                for (int i = 0; i < 16; ++i) xv[i] = xv[i] * inv * gg[i];
                uint4 o0, o1;
                o0.x = pk2(xv[0], xv[1]); o0.y = pk2(xv[2], xv[3]); o0.z = pk2(xv[4], xv[5]); o0.w = pk2(xv[6], xv[7]);
                o1.x = pk2(xv[8], xv[9]); o1.y = pk2(xv[10], xv[11]); o1.z = pk2(xv[12], xv[13]); o1.w = pk2(xv[14], xv[15]);
                *(uint4*)ptr = o0; *(uint4*)(ptr + 8) = o1;
            }
        }
        {
#pragma unroll
            for (int i3 = 0; i3 < 3; ++i3) {
                const int it = 1 * 3 + i3;
                const int ridx = it * 128 + (tid >> 2), part = tid & 3;
                const int which = ridx >= 384 ? 1 : 0, rr = ridx - which * 384, tok = rr / NH, h = rr - tok * NH;
                u16* ptr = p.PJ + (size_t)(t0 + tok) * NPJ + (which ? C_AK : C_AQ) + h * 64 + part * 16;
                const uint4 u0 = uaB[i3], u1 = ubB[i3];
                float xv[16];
                xv[0] = bflo(u0.x); xv[1] = bfhi(u0.x); xv[2] = bflo(u0.y); xv[3] = bfhi(u0.y); xv[4] = bflo(u0.z); xv[5] = bfhi(u0.z); xv[6] = bflo(u0.w); xv[7] = bfhi(u0.w);
                xv[8] = bflo(u1.x); xv[9] = bfhi(u1.x); xv[10] = bflo(u1.y); xv[11] = bfhi(u1.y); xv[12] = bflo(u1.z); xv[13] = bfhi(u1.z); xv[14] = bflo(u1.w); xv[15] = bfhi(u1.w);
                float ss = 0.f;
#pragma unroll
                for (int i = 0; i < 16; ++i) ss += xv[i] * xv[i];
                ss += __shfl_xor(ss, 1); ss += __shfl_xor(ss, 2);
                const float inv = rsqrtf(ss * (1.f / 64.f) + 1e-6f) * (which ? 1.f : 0.125f * 1.44269504089f);
                const float* gg = (which ? kn_g : qn_g) + part * 16;
#pragma unroll
                for (int i = 0; i < 16; ++i) xv[i] = xv[i] * inv * gg[i];
                uint4 o0, o1;
                o0.x = pk2(xv[0], xv[1]); o0.y = pk2(xv[2], xv[3]); o0.z = pk2(xv[4], xv[5]); o0.w = pk2(xv[6], xv[7]);
                o1.x = pk2(xv[8], xv[9]); o1.y = pk2(xv[10], xv[11]); o1.z = pk2(xv[12], xv[13]); o1.w = pk2(xv[14], xv[15]);
                *(uint4*)ptr = o0; *(uint4*)(ptr + 8) = o1;
            }
        }
#undef B1_LOAD
#undef B1_STORE
#undef B2_LOAD
        __syncthreads();
    }
}

DI f32x16 mmnt(const u16* P, const u16* Q, int tr, int tc, int r, int hh, f32x16 acc) {
#pragma unroll
    for (int s = 0; s < 4; ++s) {
        const bf16x8 a = *(const bf16x8*)(P + (32 * tr + r) * ILD + 16 * s + 8 * hh);
        const bf16x8 b = *(const bf16x8*)(Q + (32 * tc + r) * ILD + 16 * s + 8 * hh);
        acc = __builtin_amdgcn_mfma_f32_32x32x16_bf16(a, b, acc, 0, 0, 0);
    }
    return acc;
}
DI void st_eff(u16* E, const f32x16& z, int tr, int tc, int r, int hh) {
#pragma unroll
    for (int g = 0; g < 4; ++g) { uint2 o; o.x = pk2(z[4 * g], z[4 * g + 1]); o.y = pk2(z[4 * g + 2], z[4 * g + 3]); *(uint2*)(E + (32 * tc + r) * ILD + 32 * tr + 8 * g + 4 * hh) = o; }
}
DI void st_scat(u16* F, const f32x16& z, int tr, int tc, int r, int hh) {
#pragma unroll
    for (int i = 0; i < 16; ++i) F[(32 * tr + 8 * (i >> 2) + 4 * hh + (i & 3)) * ILD + 32 * tc + r] = f2bf(z[i]);
}
#define SL(n) (img + (n) * IMG)
DI void rwkv_passA(const Params& p, int l, unsigned char* shm) {
    u16* img = (u16*)shm; float* gC = (float*)(shm + 16 * IMG * 2);
    const int tid = otid(), wave = __builtin_amdgcn_readfirstlane(tid >> 6), lane = tid & 63, r = lane & 31, hh = lane >> 5;
    const int grp = wave >> 2, tr = (wave >> 1) & 1, tc = wave & 1;
    const float* mu = p.mu_a + l * 3200;
    const int q = 32 * tc + r;
    uint4 sd0, sd1, sd2, sd3, scur, sprv, sga, sgp; float sgc = 0.f, ssb = 0.f;
    const float* gn_g = p.gn_g + l * 768; const float* gn_b = p.gn_b + l * 768;
    auto stage_load = [&](int cu2) __attribute__((always_inline)) {
        const int bh2 = cu2 >> 6, ch2 = cu2 & 63, b2 = bh2 / NH, h2 = bh2 - b2 * NH, t02 = ch2 * 64;
        const int a = tid >> 7, t = (tid >> 1) & 63, half = tid & 1;
        const u16* src = p.KR + (((size_t)bh2 * SEQ + t02 + t) * 4 + a) * 64 + half * 32;
        sd0 = *(const uint4*)(src); sd1 = *(const uint4*)(src + 8); sd2 = *(const uint4*)(src + 16); sd3 = *(const uint4*)(src + 24);
        const int tv = tid >> 3, vs = (tid & 7) * 8;
        const u16* pv = p.PJ + ((size_t)b2 * SEQ + t02 + tv) * NPJ + C_V + h2 * 64 + vs;
        scur = *(const uint4*)pv;
        sprv = make_uint4(0u, 0u, 0u, 0u); sgp = make_uint4(0u, 0u, 0u, 0u);
        sga = *(const uint4*)(pv + (C_G - C_V));
        if (t02 + tv > 0) { sprv = *(const uint4*)(pv - NPJ); sgp = *(const uint4*)(pv - NPJ + (C_G - C_V)); }
        ssb = p.SBN[((size_t)b2 * SEQ + t02 + tv) * NH + h2];
        if (tid < 64) sgc = p.GC[(size_t)cu2 * 64 + tid];
    };
    if (obid() < 48 * 64) stage_load(obid());
#pragma unroll 1
    for (int cu = obid(); cu < 48 * 64; cu += gridDim.x) {
        const int bh = cu >> 6, ch = cu & 63, b = bh / NH, h = bh - b * NH, t0 = ch * 64;
        {
            const int a = tid >> 7, t = (tid >> 1) & 63, half = tid & 1;
            const uint4 d[4] = {sd0, sd1, sd2, sd3};
            u16* dst = SL(a) + t * ILD + half * 32;
#pragma unroll
            for (int j = 0; j < 4; ++j) *(uint4*)(dst + 8 * j) = d[j];
            if (a < 3) {
                u16* dT = SL(4 + a) + (half * 32) * ILD + t;
#pragma unroll
                for (int j = 0; j < 4; ++j) {
                    const unsigned w4[4] = {d[j].x, d[j].y, d[j].z, d[j].w};
#pragma unroll
                    for (int e = 0; e < 4; ++e) { dT[(8 * j + 2 * e) * ILD] = (u16)(w4[e] & 0xffffu); dT[(8 * j + 2 * e + 1) * ILD] = (u16)(w4[e] >> 16); }
                }
            }
            const int tv = tid >> 3, vs = (tid & 7) * 8;
            const unsigned cw[4] = {scur.x, scur.y, scur.z, scur.w}, pw[4] = {sprv.x, sprv.y, sprv.z, sprv.w};
            u16* vT = SL(7) + vs * ILD + tv;
            const unsigned gw[4] = {sga.x, sga.y, sga.z, sga.w}, gq[4] = {sgp.x, sgp.y, sgp.z, sgp.w};
            unsigned a1o[4], a2o[4];
#pragma unroll
            for (int e = 0; e < 4; ++e) {
                const int ch0 = h * 64 + vs + 2 * e;
                const float c0 = bflo(cw[e]), c1 = bfhi(cw[e]), p0 = bflo(pw[e]), p1 = bfhi(pw[e]);
                const float v0 = c0 + (p0 - c0) * mu[C_V + ch0], v1 = c1 + (p1 - c1) * mu[C_V + ch0 + 1];
                vT[(2 * e) * ILD] = f2bf(v0);
                vT[(2 * e + 1) * ILD] = f2bf(v1);
                const float g0 = bflo(gw[e]), g1 = bfhi(gw[e]), q0 = bflo(gq[e]), q1 = bfhi(gq[e]);
                const float sl0 = silu(g0 + (q0 - g0) * mu[C_G + ch0]), sl1 = silu(g1 + (q1 - g1) * mu[C_G + ch0 + 1]);
                a1o[e] = pk2(gn_g[ch0] * sl0, gn_g[ch0 + 1] * sl1);
                a2o[e] = pk2((gn_b[ch0] + ssb * v0) * sl0, (gn_b[ch0 + 1] + ssb * v1) * sl1);
            }
            *(uint4*)(p.HB + ((size_t)b * SEQ + t0 + tv) * DM + h * 64 + vs) = make_uint4(a1o[0], a1o[1], a1o[2], a1o[3]);
            *(uint4*)(p.PJ + ((size_t)b * SEQ + t0 + tv) * NPJ + C_K + h * 64 + vs) = make_uint4(a2o[0], a2o[1], a2o[2], a2o[3]);
            if (tid < 64) gC[tid] = sgc;
        }
        if (cu + (int)gridDim.x < 48 * 64) stage_load(cu + gridDim.x);
        __syncthreads();
        if (grp == 0) {
            f32x16 z = mmnt(SL(0), SL(1), tr, tc, r, hh, f16zero());
            f32x16 tt;
#pragma unroll
            for (int i = 0; i < 16; ++i) { const int pp = 32 * tr + 8 * (i >> 2) + 4 * hh + (i & 3); z[i] = (q < pp) ? z[i] : 0.f; tt[i] = z[i] + ((q == pp) ? 1.f : 0.f); }
            st_eff(SL(9), z, tr, tc, r, hh); st_scat(SL(8), z, tr, tc, r, hh); st_eff(SL(12), tt, tr, tc, r, hh);
        } else {
            f32x16 z = mmnt(SL(2), SL(0), tr, tc, r, hh, f16zero());
#pragma unroll
            for (int i = 0; i < 16; ++i) { const int pp = 32 * tr + 8 * (i >> 2) + 4 * hh + (i & 3); z[i] = (pp < q) ? z[i] : 0.f; }
            st_eff(SL(14), z, tr, tc, r, hh);
        }
        __syncthreads();
        if (grp == 0) { const f32x16 z = mmnt(SL(8), SL(9), tr, tc, r, hh, f16zero()); st_eff(SL(11), z, tr, tc, r, hh); st_scat(SL(10), z, tr, tc, r, hh); }
        else { const f32x16 z = mmnt(SL(14), SL(7), tr, tc, r, hh, f16zero()); st_eff(SL(15), z, tr, tc, r, hh); }
        __syncthreads();
#pragma unroll 1
        for (int m = 0; m < 4; ++m) {
            const int even = (m & 1) == 0;
            u16* Lr = even ? SL(10) : SL(8); u16* Ltr = even ? SL(11) : SL(9); u16* Lw = even ? SL(8) : SL(10); u16* Ltw = even ? SL(9) : SL(11);
            u16* TTr = even ? SL(12) : SL(13); u16* TTw = even ? SL(13) : SL(12);
            if (grp == 0) { const f32x16 z = mmnt(Lr, Ltr, tr, tc, r, hh, f16zero()); st_eff(Ltw, z, tr, tc, r, hh); st_scat(Lw, z, tr, tc, r, hh); }
            else {
                f32x16 z = mmnt(Lr, TTr, tr, tc, r, hh, f16zero());
#pragma unroll
                for (int g = 0; g < 4; ++g) { const uint2 o = *(const uint2*)(TTr + q * ILD + 32 * tr + 8 * g + 4 * hh); z[4 * g] += bflo(o.x); z[4 * g + 1] += bfhi(o.x); z[4 * g + 2] += bflo(o.y); z[4 * g + 3] += bfhi(o.y); }
                st_eff(TTw, z, tr, tc, r, hh);
            }
            __syncthreads();
        }
        if (grp == 1) {
            f32x16 z = mmnt(SL(10), SL(12), tr, tc, r, hh, f16zero());
#pragma unroll
            for (int g = 0; g < 4; ++g) { const uint2 o = *(const uint2*)(SL(12) + q * ILD + 32 * tr + 8 * g + 4 * hh); z[4 * g] += bflo(o.x); z[4 * g + 1] += bfhi(o.x); z[4 * g + 2] += bflo(o.y); z[4 * g + 3] += bfhi(o.y); }
            st_scat(SL(0), z, tr, tc, r, hh);
        } else {
            f32x16 z = mmnt(SL(1), SL(3), tr, tc, r, hh, f16zero());
#pragma unroll
            for (int i = 0; i < 16; ++i) { const int pp = 32 * tr + 8 * (i >> 2) + 4 * hh + (i & 3); z[i] = (pp <= q) ? z[i] : 0.f; }
            st_eff(SL(14), z, tr, tc, r, hh);
            z = mmnt(SL(2), SL(3), tr, tc, r, hh, f16zero());
#pragma unroll
            for (int i = 0; i < 16; ++i) { const int pp = 32 * tr + 8 * (i >> 2) + 4 * hh + (i & 3); z[i] = (pp <= q) ? z[i] : 0.f; }
            st_eff(SL(8), z, tr, tc, r, hh);
        }
        __syncthreads();
        if (grp == 0) { const f32x16 z = mmnt(SL(0), SL(15), tr, tc, r, hh, f16zero()); st_eff(SL(9), z, tr, tc, r, hh); }
        else { const f32x16 z = mmnt(SL(0), SL(4), tr, tc, r, hh, f16zero()); st_eff(SL(10), z, tr, tc, r, hh); }
        __syncthreads();
        const size_t tokq = (size_t)bh * SEQ + t0 + q;
        if (grp == 0) {
            f32x16 z = mmnt(SL(10), SL(5), tr, tc, r, hh, f16zero());
            const float gq = gC[q];
            u16* gt = p.GH + (size_t)cu * 8192 + q * 64 + 32 * tr + 4 * hh;
#pragma unroll
            for (int g = 0; g < 4; ++g) { uint2 o; o.x = pk2(z[4 * g] * gq, z[4 * g + 1] * gq); o.y = pk2(z[4 * g + 2] * gq, z[4 * g + 3] * gq); *(uint2*)(gt + 8 * g) = o; }
            z = mmnt(SL(10), SL(14), tr, tc, r, hh, f16zero());
            u16* rp = p.KR + (tokq * 4 + 3) * 64 + 32 * tr + 4 * hh;
#pragma unroll
            for (int g = 0; g < 4; ++g) {
                const uint2 o = *(const uint2*)(SL(3) + q * ILD + 32 * tr + 8 * g + 4 * hh);
                uint2 w; w.x = pk2(z[4 * g] + bflo(o.x), z[4 * g + 1] + bfhi(o.x)); w.y = pk2(z[4 * g + 2] + bflo(o.y), z[4 * g + 3] + bfhi(o.y));
                *(uint2*)(rp + 8 * g) = w;
            }
        } else {
            f32x16 z = mmnt(SL(5), SL(9), tr, tc, r, hh, f16zero());
            z = mmnt(SL(6), SL(7), tr, tc, r, hh, z);
            u16* hp = p.GH + (size_t)cu * 8192 + 4096 + q * 64 + 32 * tr + 4 * hh;
#pragma unroll
            for (int g = 0; g < 4; ++g) {
                const float4 gg = *(const float4*)(gC + 32 * tr + 8 * g + 4 * hh);
                uint2 o; o.x = pk2(z[4 * g] * gg.x, z[4 * g + 1] * gg.y); o.y = pk2(z[4 * g + 2] * gg.z, z[4 * g + 3] * gg.w);
                *(uint2*)(hp + 8 * g) = o;
            }
            z = mmnt(SL(9), SL(14), tr, tc, r, hh, f16zero());
            z = mmnt(SL(7), SL(8), tr, tc, r, hh, z);
            u16* yp = p.PJ + ((size_t)b * SEQ + t0 + q) * NPJ + C_PU + h * 64 + 32 * tr + 4 * hh;
#pragma unroll
            for (int g = 0; g < 4; ++g) { uint2 o; o.x = pk2(z[4 * g], z[4 * g + 1]); o.y = pk2(z[4 * g + 2], z[4 * g + 3]); *(uint2*)(yp + 8 * g) = o; }
        }
        __syncthreads();
    }
}

DI void rwkv_passB(const Params& p, unsigned char* shm) {
    u16* img = (u16*)shm;
    constexpr int RS = 4 * IMG + 128;
    u16* ring = img + 4 * IMG;
    const int tid = otid(), wave = __builtin_amdgcn_readfirstlane(tid >> 6), lane = tid & 63, r = lane & 31, hh = lane >> 5;
    const int bh = obid(), b = bh / NH, h = bh - b * NH;
    if (wave >= 4) {
        const int lt = tid - 256;
        auto ld = [&](int jj, int chn) __attribute__((always_inline)) -> uint4 {
            const size_t cu = (size_t)bh * 64 + chn; const int t0 = chn * 64;
            const int idx = lt + 256 * (jj & 1), row = idx >> 3, c8 = idx & 7; const u16* src;
            if ((jj >> 1) == 0) src = p.GH + cu * 8192 + row * 64 + c8 * 8;
            else if ((jj >> 1) == 1) src = p.KR + (((size_t)bh * SEQ + t0 + row) * 4 + 3) * 64 + c8 * 8;
            else if ((jj >> 1) == 2) src = p.GH + cu * 8192 + 4096 + row * 64 + c8 * 8;
            else if ((jj >> 1) == 3) src = p.PJ + ((size_t)b * SEQ + t0 + row) * NPJ + C_PU + h * 64 + c8 * 8;
            else if ((jj >> 1) == 4) src = p.HB + ((size_t)b * SEQ + t0 + row) * DM + h * 64 + c8 * 8;
            else src = p.PJ + ((size_t)b * SEQ + t0 + row) * NPJ + C_K + h * 64 + c8 * 8;
            return *(const uint4*)src;
        };
        auto stp = [&](int jj, int slot, const uint4& v) __attribute__((always_inline)) {
            const int idx = lt + 256 * (jj & 1), row = idx >> 3, c8 = idx & 7;
            *(uint4*)(ring + slot * RS + (jj >> 1) * IMG + row * ILD + c8 * 8) = v;
        };
        auto ldg = [&](int chn) __attribute__((always_inline)) -> float4 { float4 g = make_float4(0.f, 0.f, 0.f, 0.f); if (lt < 16) g = *(const float4*)(p.GC + ((size_t)bh * 64 + chn) * 64 + lt * 4); return g; };
        auto stg = [&](int slot, const float4& g) __attribute__((always_inline)) { if (lt < 16) *(float4*)((float*)(ring + slot * RS + 4 * IMG) + lt * 4) = g; };
        auto emit = [&](int chn, int j2, const uint4& a1, const uint4& a2) __attribute__((always_inline)) {
            const int idx = lt + 256 * j2, row = idx >> 3, c8 = idx & 7;
            const uint4 nv = *(const uint4*)(img + (2 + (chn & 1)) * IMG + row * ILD + c8 * 8);
            const unsigned nn[4] = {nv.x, nv.y, nv.z, nv.w}, x1[4] = {a1.x, a1.y, a1.z, a1.w}, x2[4] = {a2.x, a2.y, a2.z, a2.w};
            unsigned o[4];
#pragma unroll
            for (int e = 0; e < 4; ++e) o[e] = pk2(bflo(nn[e]) * bflo(x1[e]) + bflo(x2[e]), bfhi(nn[e]) * bfhi(x1[e]) + bfhi(x2[e]));
            *(uint4*)(p.HB + ((size_t)b * SEQ + chn * 64 + row) * DM + h * 64 + c8 * 8) = make_uint4(o[0], o[1], o[2], o[3]);
        };
#define PB_DECL(S) uint4 a##S##0, a##S##1, a##S##2, a##S##3, a##S##4, a##S##5, a##S##6, a##S##7; float4 g##S
#define PB_ISSUE(S, CH) do { a##S##0 = ld(0, CH); a##S##1 = ld(1, CH); a##S##2 = ld(2, CH); a##S##3 = ld(3, CH); a##S##4 = ld(4, CH); a##S##5 = ld(5, CH); a##S##6 = ld(6, CH); a##S##7 = ld(7, CH); g##S = ldg(CH); } while (0)
#define PB_WRITE(S, SLOT) do { stp(0, SLOT, a##S##0); stp(1, SLOT, a##S##1); stp(2, SLOT, a##S##2); stp(3, SLOT, a##S##3); stp(4, SLOT, a##S##4); stp(5, SLOT, a##S##5); stp(6, SLOT, a##S##6); stp(7, SLOT, a##S##7); stg(SLOT, g##S); } while (0)
#define PA_DECL(S) uint4 f##S##0, f##S##1, f##S##2, f##S##3
#define PA_ISSUE(S, CH) do { f##S##0 = ld(8, CH); f##S##1 = ld(9, CH); f##S##2 = ld(10, CH); f##S##3 = ld(11, CH); } while (0)
#define PA_EMIT(S, CH) do { emit(CH, 0, f##S##0, f##S##2); emit(CH, 1, f##S##1, f##S##3); } while (0)
        PB_DECL(0); PB_DECL(1);
        PA_DECL(0); PA_DECL(1); PA_DECL(2); PA_DECL(3); PA_DECL(4); PA_DECL(5);
        PB_ISSUE(0, 0); PB_ISSUE(1, 1);
        PA_ISSUE(0, 0); PA_ISSUE(1, 1); PA_ISSUE(2, 2); PA_ISSUE(3, 3);
        PB_WRITE(0, 0); PB_ISSUE(0, 2);
        PB_WRITE(1, 1); PB_ISSUE(1, 3);
        __syncthreads();
#define PB_STEP(U, RSET, SLOT, AEM, AIS) do { const int st = c6 + (U); if (st < 64) { \
            if (st >= 1) PA_EMIT(AEM, st - 1); \
            if (st + 2 < 64) { PB_WRITE(RSET, SLOT); if (st + 4 < 64) PB_ISSUE(RSET, st + 4); } \
            if (st + 4 < 64) PA_ISSUE(AIS, st + 4); \
            __syncthreads(); } } while (0)
#pragma unroll 1
        for (int c6 = 0; c6 < 66; c6 += 6) {
            PB_STEP(0, 0, 2, 5, 4); PB_STEP(1, 1, 0, 0, 5); PB_STEP(2, 0, 1, 1, 0); PB_STEP(3, 1, 2, 2, 1); PB_STEP(4, 0, 0, 3, 2); PB_STEP(5, 1, 1, 4, 3);
        }
        PA_EMIT(3, 63);
#undef PB_STEP
#undef PB_DECL
#undef PB_ISSUE
#undef PB_WRITE
#undef PA_DECL
#undef PA_ISSUE
#undef PA_EMIT
        return;
    }
    if (wave >= 2) {
        const int tr = wave - 2;
        f32x16 S0 = f16zero(), S1 = f16zero();
        st_eff(SL(0), S0, tr, 0, r, hh); st_eff(SL(0), S1, tr, 1, r, hh);
        __syncthreads();
#pragma unroll 1
        for (int ch = 0; ch < 64; ++ch) {
            const u16* Si = SL(ch & 1);
            const u16* rs = ring + (ch % 3) * RS;
            const u16 *GTi = rs, *Hi = rs + 2 * IMG; const float* gCi = (const float*)(rs + 4 * IMG);
            f32x16 z0 = f16zero(), z1 = f16zero();
#pragma unroll
            for (int s = 0; s < 4; ++s) {
                const bf16x8 ga = *(const bf16x8*)(GTi + (32 * tr + r) * ILD + 16 * s + 8 * hh);
                const bf16x8 sb0 = *(const bf16x8*)(Si + r * ILD + 16 * s + 8 * hh), sb1 = *(const bf16x8*)(Si + (32 + r) * ILD + 16 * s + 8 * hh);
                z0 = __builtin_amdgcn_mfma_f32_32x32x16_bf16(ga, sb0, z0, 0, 0, 0);
                z1 = __builtin_amdgcn_mfma_f32_32x32x16_bf16(ga, sb1, z1, 0, 0, 0);
            }
#pragma unroll
            for (int g = 0; g < 4; ++g) {
                const float4 gg = *(const float4*)(gCi + 32 * tr + 8 * g + 4 * hh);
                const uint2 h0 = *(const uint2*)(Hi + r * ILD + 32 * tr + 8 * g + 4 * hh), h1 = *(const uint2*)(Hi + (32 + r) * ILD + 32 * tr + 8 * g + 4 * hh);
                S0[4 * g] = S0[4 * g] * gg.x + z0[4 * g] + bflo(h0.x); S0[4 * g + 1] = S0[4 * g + 1] * gg.y + z0[4 * g + 1] + bfhi(h0.x);
                S0[4 * g + 2] = S0[4 * g + 2] * gg.z + z0[4 * g + 2] + bflo(h0.y); S0[4 * g + 3] = S0[4 * g + 3] * gg.w + z0[4 * g + 3] + bfhi(h0.y);
                S1[4 * g] = S1[4 * g] * gg.x + z1[4 * g] + bflo(h1.x); S1[4 * g + 1] = S1[4 * g + 1] * gg.y + z1[4 * g + 1] + bfhi(h1.x);
                S1[4 * g + 2] = S1[4 * g + 2] * gg.z + z1[4 * g + 2] + bflo(h1.y); S1[4 * g + 3] = S1[4 * g + 3] * gg.w + z1[4 * g + 3] + bfhi(h1.y);
            }
            st_eff(SL((ch + 1) & 1), S0, tr, 0, r, hh); st_eff(SL((ch + 1) & 1), S1, tr, 1, r, hh);
            __syncthreads();
        }
        return;
    }
    {
        const int tc = wave, q = 32 * tc + r;
        __syncthreads();
#pragma unroll 1
        for (int ch = 0; ch < 64; ++ch) {
            const u16* Si = SL(ch & 1);
            const u16* rs = ring + (ch % 3) * RS;
            const u16 *RPi = rs + IMG, *YVi = rs + 3 * IMG;
            u16* Ni = img + (2 + (ch & 1)) * IMG;
            f32x16 z0 = f16zero(), z1 = f16zero();
#pragma unroll
            for (int s = 0; s < 4; ++s) {
                const bf16x8 rb = *(const bf16x8*)(RPi + q * ILD + 16 * s + 8 * hh);
                const bf16x8 sa0 = *(const bf16x8*)(Si + r * ILD + 16 * s + 8 * hh), sa1 = *(const bf16x8*)(Si + (32 + r) * ILD + 16 * s + 8 * hh);
                z0 = __builtin_amdgcn_mfma_f32_32x32x16_bf16(sa0, rb, z0, 0, 0, 0);
                z1 = __builtin_amdgcn_mfma_f32_32x32x16_bf16(sa1, rb, z1, 0, 0, 0);
            }
            float s1 = 0.f, s2 = 0.f;
#pragma unroll
            for (int g = 0; g < 4; ++g) {
                const uint2 y0 = *(const uint2*)(YVi + q * ILD + 8 * g + 4 * hh), y1 = *(const uint2*)(YVi + q * ILD + 32 + 8 * g + 4 * hh);
                z0[4 * g] += bflo(y0.x); z0[4 * g + 1] += bfhi(y0.x); z0[4 * g + 2] += bflo(y0.y); z0[4 * g + 3] += bfhi(y0.y);
                z1[4 * g] += bflo(y1.x); z1[4 * g + 1] += bfhi(y1.x); z1[4 * g + 2] += bflo(y1.y); z1[4 * g + 3] += bfhi(y1.y);
#pragma unroll
                for (int e = 0; e < 4; ++e) { s1 += z0[4 * g + e] + z1[4 * g + e]; s2 += z0[4 * g + e] * z0[4 * g + e] + z1[4 * g + e] * z1[4 * g + e]; }
            }
            s1 += __shfl_xor(s1, 32); s2 += __shfl_xor(s2, 32);
            const float mean = s1 * (1.f / 64.f);
            const float rstd = rsqrtf(fmaxf(s2 * (1.f / 64.f) - mean * mean, 0.f) + 64e-5f);
#pragma unroll
            for (int g = 0; g < 4; ++g) {
                uint2 o0, o1;
                o0.x = pk2((z0[4 * g] - mean) * rstd, (z0[4 * g + 1] - mean) * rstd); o0.y = pk2((z0[4 * g + 2] - mean) * rstd, (z0[4 * g + 3] - mean) * rstd);
                o1.x = pk2((z1[4 * g] - mean) * rstd, (z1[4 * g + 1] - mean) * rstd); o1.y = pk2((z1[4 * g + 2] - mean) * rstd, (z1[4 * g + 3] - mean) * rstd);
                *(uint2*)(Ni + q * ILD + 8 * g + 4 * hh) = o0; *(uint2*)(Ni + q * ILD + 32 + 8 * g + 4 * hh) = o1;
            }
            __syncthreads();
        }
    }
}
#undef SL

DI void attn_unit(const Params& p, int unit) {
    const int lane = otid() & 63, r = lane & 31, hh = lane >> 5;
    const int bh = unit >> 7, qt = unit & 127, b = bh / NH, h = bh - b * NH;
    const int q0 = qt * 32, qrow = q0 + r;
    const u16* pjb = p.PJ + (size_t)b * SEQ * NPJ;
    bf16x8 qf[4];
#pragma unroll
    for (int ks = 0; ks < 4; ++ks) qf[ks] = *(const bf16x8*)(pjb + (size_t)(q0 + r) * NPJ + C_AQ + h * 64 + ks * 16 + hh * 8);
    f32x16 O0, O1;
#pragma unroll
    for (int i = 0; i < 16; ++i) { O0[i] = 0.f; O1[i] = 0.f; }
    float carry = 0.f;
    bf16x8 kf[4], v00, v01, v10, v11;
#define AT_LOAD(KF, V00, V01, V10, V11, KT) do { const int _k0 = (KT) * 32; \
        _Pragma("unroll") for (int ks = 0; ks < 4; ++ks) KF[ks] = *(const bf16x8*)(pjb + (size_t)(_k0 + r) * NPJ + C_AK + h * 64 + ks * 16 + hh * 8); \
        const u16* _vfp = p.VF + (((size_t)bh * 128 + (KT)) * 4) * 512 + lane * 8; \
        V00 = *(const bf16x8*)(_vfp); V01 = *(const bf16x8*)(_vfp + 512); V10 = *(const bf16x8*)(_vfp + 1024); V11 = *(const bf16x8*)(_vfp + 1536); } while (0)
    AT_LOAD(kf, v00, v01, v10, v11, qt);
    bf16x8 kf2[4], w00, w01, w10, w11;
    if (qt > 0) AT_LOAD(kf2, w00, w01, w10, w11, qt - 1);
    const u16* gp = p.PJ + ((size_t)b * SEQ + q0 + r) * NPJ + C_AG + h * 64;
    uint2 gu[8];
#pragma unroll
    for (int i = 0; i < 8; ++i) gu[i] = *(const uint2*)(gp + (i >> 2) * 32 + 8 * (i & 3) + 4 * hh);
#pragma unroll 1
    for (int kt = qt; kt >= 0; --kt) {
        const int k0 = kt * 32;
        bf16x8 kf3[4], x00, x01, x10, x11;
        if (kt > 1) AT_LOAD(kf3, x00, x01, x10, x11, kt - 2);
        f32x16 z;
#pragma unroll
        for (int i = 0; i < 16; ++i) z[i] = 0.f;
#pragma unroll
        for (int ks = 0; ks < 4; ++ks) z = __builtin_amdgcn_mfma_f32_32x32x16_bf16(kf[ks], qf[ks], z, 0, 0, 0);
        float l1m[16], lb[16];
#pragma unroll
        for (int i = 0; i < 16; ++i) {
            const int key = k0 + (i & 3) + 8 * (i >> 2) + 4 * hh;
            const float zz = z[i];
            const float sp = fmaxf(zz, 0.f) + __builtin_amdgcn_logf(1.f + __builtin_amdgcn_exp2f(-fabsf(zz)));
            l1m[i] = (key < qrow) ? -sp : 0.f;
            lb[i] = (key < qrow) ? (zz - sp) : -1e30f;
        }
        float Gs[4], Gp[4];
#pragma unroll
        for (int g = 0; g < 4; ++g) { Gs[g] = (l1m[4 * g] + l1m[4 * g + 1]) + (l1m[4 * g + 2] + l1m[4 * g + 3]); Gp[g] = __shfl_xor(Gs[g], 32); }
        float E[4];
        const float keep = hh ? 0.f : 1.f;
        E[3] = keep * Gp[3];
        E[2] = Gs[3] + Gp[3] + keep * Gp[2];
        E[1] = Gs[3] + Gs[2] + Gp[3] + Gp[2] + keep * Gp[1];
        E[0] = Gs[3] + Gs[2] + Gs[1] + Gp[3] + Gp[2] + Gp[1] + keep * Gp[0];
        float w[16];
#pragma unroll
        for (int g = 0; g < 4; ++g) {
            float a = carry + E[g];
            w[4 * g + 3] = __builtin_amdgcn_exp2f(lb[4 * g + 3] + a); a += l1m[4 * g + 3];
            w[4 * g + 2] = __builtin_amdgcn_exp2f(lb[4 * g + 2] + a); a += l1m[4 * g + 2];
            w[4 * g + 1] = __builtin_amdgcn_exp2f(lb[4 * g + 1] + a); a += l1m[4 * g + 1];
            w[4 * g + 0] = __builtin_amdgcn_exp2f(lb[4 * g + 0] + a);
        }
        carry += (Gs[0] + Gs[1]) + (Gs[2] + Gs[3]) + (Gp[0] + Gp[1]) + (Gp[2] + Gp[3]);
        union { unsigned u[4]; bf16x8 v; } x0, x1;
#pragma unroll
        for (int j = 0; j < 4; ++j) { x0.u[j] = pk2(w[2 * j], w[2 * j + 1]); x1.u[j] = pk2(w[8 + 2 * j], w[8 + 2 * j + 1]); }
        O0 = __builtin_amdgcn_mfma_f32_32x32x16_bf16(v00, x0.v, O0, 0, 0, 0);
        O1 = __builtin_amdgcn_mfma_f32_32x32x16_bf16(v01, x0.v, O1, 0, 0, 0);
        O0 = __builtin_amdgcn_mfma_f32_32x32x16_bf16(v10, x1.v, O0, 0, 0, 0);
        O1 = __builtin_amdgcn_mfma_f32_32x32x16_bf16(v11, x1.v, O1, 0, 0, 0);
        if (__all(carry < -150.f)) break;
        if (kt > 0) {
#pragma unroll
            for (int ks = 0; ks < 4; ++ks) { kf[ks] = kf2[ks]; kf2[ks] = kf3[ks]; }
            v00 = w00; v01 = w01; v10 = w10; v11 = w11;
            w00 = x00; w01 = x01; w10 = x10; w11 = x11;
        }
    }
#undef AT_LOAD
    const size_t row = (size_t)b * SEQ + q0 + r;
    u16* mp = p.HB + row * DM + 1280 + h * 64;
#pragma unroll
    for (int dblk = 0; dblk < 2; ++dblk)
#pragma unroll
        for (int g = 0; g < 4; ++g) {
            const int d = dblk * 32 + 8 * g + 4 * hh;
            const uint2 gv = gu[dblk * 4 + g];
            const float o0 = dblk ? O1[4 * g + 0] : O0[4 * g + 0], o1 = dblk ? O1[4 * g + 1] : O0[4 * g + 1], o2 = dblk ? O1[4 * g + 2] : O0[4 * g + 2], o3 = dblk ? O1[4 * g + 3] : O0[4 * g + 3];
            uint2 o; o.x = pk2(o0 * silu(bflo(gv.x)), o1 * silu(bfhi(gv.x))); o.y = pk2(o2 * silu(bflo(gv.y)), o3 * silu(bfhi(gv.y)));
            *(uint2*)(mp + d) = o;
        }
}

DI void phase_p4b(const Params& p, int l, unsigned char* shm) {
    constexpr int NB = 48, UA = 6144;
    const int wave = __builtin_amdgcn_readfirstlane(otid() >> 6);
    if (obid() < NB) {
        rwkv_passB(p, shm);
        for (int u = UA + obid() * 8 + wave; u < 48 * 128; u += NB * 8) attn_unit(p, u);
        return;
    }
    for (int u = (obid() - NB) * 8 + wave; u < UA; u += (gridDim.x - NB) * 8) attn_unit(p, u);
    if (l == 0) { __syncthreads(); convert_weights(p, 1, shm, obid() - NB, gridDim.x - NB, 0, 32 * (NPJ / 256)); }
}

DI void run_phase(const Params& p, int ph, int l, unsigned char* shm) {
    switch (ph) {
    case 0: phase_p1(p, l, shm); break;
    case 1: { pg8::Gemm g{p.HB, p.W1, MTOK, NG1, DM}; pg8::StaticOrder S; S.init(MTOK, NG1, gridDim.x, obid()); pg8::EpiBf16 E{p.PJ, NPJ};
              pg8::gemm_phase<pg8::EpiBf16, pg8::StaticOrder>((PG8_LAS unsigned char*)shm, g, S, E); } break;
    case 2: phase_p3(p, l, shm); break;
    case 3: rwkv_passA(p, l, shm); break;
    case 4: phase_p4b(p, l, shm); break;
    case 6: { pg8::Gemm g{p.HB, p.W2, MTOK, DM, DM}; pg8::StaticOrder S; S.init(MTOK, DM, gridDim.x, obid()); pg8::EpiRes E{l == 0 ? p.x : p.out, p.out, DM};
              pg8::gemm_phase<pg8::EpiRes, pg8::StaticOrder>((PG8_LAS unsigned char*)shm, g, S, E); } break;
    }
}

#if MK_COOP
__global__ __launch_bounds__(512, 2) void mk_fwd(Params p, int ph_lo, int ph_hi) {
    extern __shared__ __attribute__((aligned(16))) unsigned char shm[];
    volatile LAS unsigned* st = (volatile LAS unsigned*)((LAS unsigned char*)shm + 148 * 1024);
    if (threadIdx.x < 2) st[threadIdx.x] = 0u;
    __syncthreads();
    const XcdBarrier xb = xcd_barrier_post(p.BAR, st);
    if (p.x == nullptr) cg::this_grid().sync();
#pragma unroll 1
    for (int l = 0; l < 2; ++l) {
        run_phase(p, 0, l, shm); xcd_barrier(xb);
        run_phase(p, 1, l, shm); xcd_barrier(xb);
        run_phase(p, 2, l, shm); xcd_barrier(xb);
        run_phase(p, 3, l, shm); xcd_barrier(xb);
        run_phase(p, 4, l, shm); xcd_barrier(xb);
        run_phase(p, 6, l, shm); if (l == 0) xcd_barrier(xb);
    }
}
#define MK_KERNEL mk_fwd
#else
template <int PH> __global__ __launch_bounds__(512, 2) void k_ph(Params p, int l) {
    extern __shared__ __attribute__((aligned(16))) unsigned char shm[];
    run_phase(p, PH, l, shm);
}
#define MK_KERNEL k_ph<1>
#endif

extern "C" void kernel_launch(void* const* d_in, const int* in_sizes, int n_in, void* d_out, int out_size, void* d_ws, size_t ws_size, hipStream_t stream) {
    static int grid = 0;
    if (grid == 0) {
        int dev = 0, cus = 0, per_cu = 0;
        (void)hipGetDevice(&dev); (void)hipDeviceGetAttribute(&cus, hipDeviceAttributeMultiprocessorCount, dev);
#if MK_COOP
        if (hipFuncSetAttribute((const void*)mk_fwd, hipFuncAttributeMaxDynamicSharedMemorySize, LDS_BYTES) != hipSuccess) { fprintf(stderr, "kernel_launch: hipFuncSetAttribute failed\n"); grid = -1; return; }
#else
        (void)hipFuncSetAttribute((const void*)k_ph<0>, hipFuncAttributeMaxDynamicSharedMemorySize, LDS_BYTES); (void)hipFuncSetAttribute((const void*)k_ph<1>, hipFuncAttributeMaxDynamicSharedMemorySize, LDS_BYTES);
        (void)hipFuncSetAttribute((const void*)k_ph<2>, hipFuncAttributeMaxDynamicSharedMemorySize, LDS_BYTES); (void)hipFuncSetAttribute((const void*)k_ph<3>, hipFuncAttributeMaxDynamicSharedMemorySize, LDS_BYTES);
        (void)hipFuncSetAttribute((const void*)k_ph<4>, hipFuncAttributeMaxDynamicSharedMemorySize, LDS_BYTES); (void)hipFuncSetAttribute((const void*)k_ph<5>, hipFuncAttributeMaxDynamicSharedMemorySize, LDS_BYTES);
        (void)hipFuncSetAttribute((const void*)k_ph<6>, hipFuncAttributeMaxDynamicSharedMemorySize, LDS_BYTES);
#endif
        if (hipOccupancyMaxActiveBlocksPerMultiprocessor(&per_cu, (const void*)MK_KERNEL, 512, LDS_BYTES) != hipSuccess || per_cu < 1) { fprintf(stderr, "kernel_launch: occupancy query gave %d\n", per_cu); per_cu = 1; }
        (void)hipGetLastError();
        grid = cus * per_cu;
    }
    if (grid < 0) return;
    Params p{};
    const float* const* in = (const float* const*)d_in;
    p.x = in[0]; p.norm_g = in[1]; p.w_in = in[2]; p.mu_a = in[3]; p.w_up = in[4]; p.w0 = in[5]; p.a_up = in[6]; p.a0 = in[7]; p.k_k = in[8]; p.k_a = in[9]; p.r_k = in[10];
    p.gn_g = in[11]; p.gn_b = in[12]; p.pool_w = in[13]; p.pool_scale = in[14]; p.qn_g = in[15]; p.kn_g = in[16]; p.w_out = in[17];
    p.out = (float*)d_out;
    unsigned char* ws = (unsigned char*)d_ws; size_t off = 0;
    auto take = [&](size_t bytes) { unsigned char* q = ws + off; off += (bytes + 255) & ~(size_t)255; return q; };
    p.W1 = (u16*)take((size_t)NPJ * DM * 2); p.W2 = (u16*)take((size_t)DM * DM * 2); p.HB = (u16*)take((size_t)MTOK * DM * 2); p.PJ = (u16*)take((size_t)MTOK * NPJ * 2);
    p.KR = (u16*)take((size_t)48 * SEQ * 256 * 2); p.VF = (u16*)take((size_t)48 * SEQ * 64 * 2); p.GH = (u16*)take((size_t)48 * 64 * 8192 * 2);
    p.WUT = (u16*)take(768 * 64 * 2); p.AUT = (u16*)take(768 * 64 * 2); p.PWT = (u16*)take(4 * 128 * 128 * 2);
    p.GC = (float*)take((size_t)48 * 64 * 64 * 4); p.SBN = (float*)take((size_t)MTOK * NH * 4); p.BAR = (unsigned*)take(XCD_BAR_WORDS * 4);
    if (off > ws_size) { fprintf(stderr, "kernel_launch: workspace too small: need %zu, have %zu\n", off, ws_size); return; }
    if (hipMemsetAsync(p.BAR, 0, XCD_BAR_WORDS * 4, stream) != hipSuccess) { fprintf(stderr, "kernel_launch: memset of the barrier words failed\n"); return; }
#if MK_COOP
    int lo = 0, hi = 12;
    void* args[] = {&p, &lo, &hi};
    hipError_t e = hipLaunchCooperativeKernel((const void*)mk_fwd, dim3(grid), dim3(512), args, LDS_BYTES, stream);
    if (e != hipSuccess) fprintf(stderr, "cooperative launch failed: %s (grid %d)\n", hipGetErrorString(e), grid);
#else
    for (int l = 0; l < 2; ++l) {
        hipLaunchKernelGGL(k_ph<0>, dim3(grid), dim3(512), LDS_BYTES, stream, p, l);
        hipLaunchKernelGGL(k_ph<1>, dim3(grid), dim3(512), LDS_BYTES, stream, p, l);
        hipLaunchKernelGGL(k_ph<2>, dim3(grid), dim3(512), LDS_BYTES, stream, p, l);
        hipLaunchKernelGGL(k_ph<3>, dim3(grid), dim3(512), LDS_BYTES, stream, p, l);
        hipLaunchKernelGGL(k_ph<4>, dim3(grid), dim3(512), LDS_BYTES, stream, p, l);
        hipLaunchKernelGGL(k_ph<5>, dim3(grid), dim3(512), LDS_BYTES, stream, p, l);
        hipLaunchKernelGGL(k_ph<6>, dim3(grid), dim3(512), LDS_BYTES, stream, p, l);
    }
#endif
}
```
